# Optimizing an MI355X kernel written in HIP

```python
import math
import jax, jax.numpy as jnp
from jax import lax
import numpy as np

D_MODEL = 1024
BATCH = 8
SEQ = 4096
DEPTH = 2
DEC_BATCH = 128
DEC_SEQ = 4
PAST_LEN = 16384
PAGE_SIZE = 128

N_EVEN = (DEPTH + 1) // 2
N_ODD = DEPTH // 2
CONV_K = 3
EPS = 1e-6
A_WIDTH = D_MODEL // 2
B_HEADS = 8
B_KV_HEADS = 2
B_GROUP = B_HEADS // B_KV_HEADS
B_HEAD_DIM = (D_MODEL // 2) // B_HEADS
WINDOW = 128
AB_SPLITS = [A_WIDTH, 2 * A_WIDTH, 3 * A_WIDTH, 3 * A_WIDTH + B_HEADS * B_HEAD_DIM,
             3 * A_WIDTH + (B_HEADS + B_KV_HEADS) * B_HEAD_DIM]
D_IN_AB = 3 * A_WIDTH + (B_HEADS + 2 * B_KV_HEADS) * B_HEAD_DIM
D_MIX_AB = A_WIDTH + B_HEADS * B_HEAD_DIM
C_HEADS = 8
C_DK = 128
C_DV = D_MODEL // C_HEADS
C_DK_T = C_HEADS * C_DK
C_DV_T = C_HEADS * C_DV
D_IN_C = 2 * C_DK_T + 2 * C_DV_T
HGRN_CHUNK = 64
D_FF = ((8 * D_MODEL // 3 + 255) // 256) * 256

kernel_name = 'hybrid_shortconv_swa_hgrn2_convffn_step'


def rms_norm(x, g):
    x32 = x.astype(jnp.float32)
    y = x32 * lax.rsqrt(jnp.mean(x32 * x32, axis=-1, keepdims=True) + EPS) * g.astype(jnp.float32)
    return y.astype(x.dtype)


def causal_dwconv(u, prev, w):
    L = u.shape[1]
    full = jnp.concatenate([prev.astype(u.dtype), u], axis=1)
    y = full[:, 0:L] * w[0]
    for j in range(1, CONV_K):
        y = y + full[:, j:j + L] * w[j]
    return y, full[:, L:]


def alibi_slopes(n):
    return jnp.exp2(-8.0 * jnp.arange(1, n + 1, dtype=jnp.float32) / n)


def window_attention(qb, kb, vb, qpos, kpos, sinks):
    f32 = jnp.float32
    s = jnp.einsum('bnqkgd,bnskd->bnkgqs', qb.astype(f32), kb.astype(f32)) * (B_HEAD_DIM ** -0.5)
    dist = qpos[:, :, None] - kpos[:, None, :]
    valid = (kpos[:, None, :] >= 0) & (dist >= 0) & (dist < WINDOW)
    slopes = alibi_slopes(B_HEADS).reshape(B_KV_HEADS, B_GROUP)
    s = s - slopes[None, None, :, :, None, None] * dist.astype(f32)[None, :, None, None]
    s = jnp.where(valid[None, :, None, None], s, -jnp.inf)
    sink = sinks.astype(f32).reshape(1, 1, B_KV_HEADS, B_GROUP, 1)
    m = jnp.maximum(jnp.max(s, axis=-1), sink)
    p = jnp.exp(s - m[..., None])
    denom = jnp.sum(p, axis=-1) + jnp.exp(sink - m)
    o = jnp.einsum('bnkgqs,bnskd->bnqkgd', p / denom[..., None], vb.astype(f32))
    return o


def mixer_ab(xn, conv_prev, k_buf, v_buf, w_in, conv_w, sinks, w_out):
    Bsz, L, _ = xn.shape
    h, gb, gc, q, k, v = jnp.split(xn @ w_in, AB_SPLITS, axis=-1)
    ya, new_conv = causal_dwconv(gc * h, conv_prev, conv_w)
    ya = gb * ya
    q = q.reshape(Bsz, L, B_KV_HEADS, B_GROUP, B_HEAD_DIM)
    k = k.reshape(Bsz, L, B_KV_HEADS, B_HEAD_DIM)
    v = v.reshape(Bsz, L, B_KV_HEADS, B_HEAD_DIM)
    if k_buf is None:
        nb = L // WINDOW
        qb = q.reshape(Bsz, nb, WINDOW, B_KV_HEADS, B_GROUP, B_HEAD_DIM)
        pad = jnp.zeros((Bsz, WINDOW, B_KV_HEADS, B_HEAD_DIM), k.dtype)
        kp = jnp.concatenate([pad, k], axis=1).reshape(Bsz, nb + 1, WINDOW, B_KV_HEADS, B_HEAD_DIM)
        vp = jnp.concatenate([pad, v], axis=1).reshape(Bsz, nb + 1, WINDOW, B_KV_HEADS, B_HEAD_DIM)
        kb = jnp.concatenate([kp[:, :-1], kp[:, 1:]], axis=2)
        vb = jnp.concatenate([vp[:, :-1], vp[:, 1:]], axis=2)
        start = jnp.arange(nb, dtype=jnp.int32)[:, None] * WINDOW
        qpos = start + jnp.arange(WINDOW, dtype=jnp.int32)[None]
        kpos = start - WINDOW + jnp.arange(2 * WINDOW, dtype=jnp.int32)[None]
        keep = min(WINDOW, L)
        new_k, new_v = k[:, L - keep:], v[:, L - keep:]
    else:
        Wb = k_buf.shape[1]
        kc = jnp.concatenate([k_buf.astype(k.dtype), k], axis=1)
        vc = jnp.concatenate([v_buf.astype(v.dtype), v], axis=1)
        qb, kb, vb = q[:, None], kc[:, None], vc[:, None]
        qpos = (PAST_LEN + jnp.arange(L, dtype=jnp.int32))[None]
        kpos = (PAST_LEN - Wb + jnp.arange(Wb + L, dtype=jnp.int32))[None]
        new_k, new_v = kc[:, L:], vc[:, L:]
    yb = window_attention(qb, kb, vb, qpos, kpos, sinks).reshape(Bsz, L, B_HEADS * B_HEAD_DIM).astype(xn.dtype)
    out = jnp.concatenate([ya, yb], axis=-1) @ w_out
    return out, new_conv, new_k, new_v


def gla_chunked(q, k, v, log_f, S0):
    Bsz, L, H, DK = q.shape
    DV = v.shape[-1]
    C = math.gcd(HGRN_CHUNK, L)
    n = L // C
    def to_chunks(a):
        return a.reshape(Bsz, n, C, H, a.shape[-1]).transpose(1, 0, 3, 2, 4)
    causal = jnp.tril(jnp.ones((C, C), dtype=bool))
    def step(S, inp):
        qc, kc, vc, lc = inp
        G = jnp.cumsum(lc, axis=2)
        diff = G[:, :, :, None, :] - G[:, :, None, :, :]
        decay = jnp.exp(jnp.where(causal[:, :, None], diff, -jnp.inf))
        A = jnp.einsum('bhtd,bhsd,bhtsd->bhts', qc, kc, decay)
        o = jnp.einsum('bhts,bhse->bhte', A, vc) + jnp.einsum('bhtd,bhde->bhte', qc * jnp.exp(G), S)
        Gl = G[:, :, -1]
        S = jnp.exp(Gl)[..., None] * S + jnp.einsum('bhsd,bhse->bhde', kc * jnp.exp(Gl[:, :, None] - G), vc)
        return S, o
    S, o = lax.scan(step, S0, (to_chunks(q), to_chunks(k), to_chunks(v), to_chunks(log_f)))
    o = o.transpose(1, 0, 3, 2, 4).reshape(Bsz, L, H, DV)
    return o, S


def hgrn_lower_bounds(logits):
    pr = jax.nn.softmax(logits.astype(jnp.float32), axis=0)
    return jnp.clip(jnp.cumsum(pr, axis=0) - pr[0:1], 0.0, 1.0)


def mixer_c(xn, S0, w_in, lb, norm_g, w_out):
    Bsz, L, _ = xn.shape
    f32 = jnp.float32
    q, f, i, g = jnp.split(xn @ w_in, [C_DK_T, 2 * C_DK_T, 2 * C_DK_T + C_DV_T], axis=-1)
    fl = f.astype(f32)
    log_f = jnp.logaddexp(jnp.log(lb), jnp.log1p(-lb) + jax.nn.log_sigmoid(fl))
    k_in = (1.0 - lb) * jax.nn.sigmoid(-fl)
    shp = (Bsz, L, C_HEADS, C_DK)
    o, S = gla_chunked(q.astype(f32).reshape(shp), k_in.reshape(shp),
                       i.astype(f32).reshape(Bsz, L, C_HEADS, C_DV), log_f.reshape(shp), S0.astype(f32))
    o = rms_norm(o, norm_g).reshape(Bsz, L, C_DV_T) * jax.nn.silu(g.astype(f32))
    return o.astype(xn.dtype) @ w_out, S.astype(S0.dtype)


def conv_ffn(xn, prev, w_up, conv_w, w_down):
    a, b = jnp.split(xn @ w_up, 2, axis=-1)
    a, new_prev = causal_dwconv(a, prev, conv_w)
    return (jax.nn.gelu(a) * b) @ w_down, new_prev


def run_trunk(x, conv_a_prev, k_buf, v_buf, hgrn_prev, ffn_prev, p):
    conv_new, k_new, v_new, s_new, ffn_new = [], [], [], [], []
    lbs = hgrn_lower_bounds(p['hgrn_lb_logits'])
    for l in range(DEPTH):
        j = l // 2
        h = rms_norm(x, p['norm_mix_pre'][l])
        if l % 2 == 0:
            mix, c, kk, vv = mixer_ab(h, conv_a_prev[j], None if k_buf is None else k_buf[j],
                                      None if v_buf is None else v_buf[j], p['w_in_ab'][j],
                                      p['conv_a_w'][j], p['attn_sinks'][j], p['w_out_ab'][j])
            conv_new.append(c); k_new.append(kk); v_new.append(vv)
        else:
            mix, S = mixer_c(h, hgrn_prev[j], p['w_in_c'][j], lbs[l], p['hgrn_norm_g'][j], p['w_out_c'][j])
            s_new.append(S)
        x = x + rms_norm(mix, p['norm_mix_post'][l])
        h = rms_norm(x, p['norm_ffn_pre'][l])
        fo, fs = conv_ffn(h, ffn_prev[l], p['w_ffn_up'][l], p['ffn_conv_w'][l], p['w_ffn_down'][l])
        ffn_new.append(fs)
        x = x + rms_norm(fo, p['norm_ffn_post'][l])
    return x, jnp.stack(conv_new), jnp.stack(k_new), jnp.stack(v_new), jnp.stack(s_new), jnp.stack(ffn_new)


def setup_inputs(seed: int = 0) -> dict:
    key = jax.random.key(seed)
    ks = jax.random.split(key, 24)
    f32 = jnp.float32
    def nrm(k, shape, scale=1.0):
        return scale * jax.random.normal(k, shape, f32)
    win_buf = min(WINDOW, PAST_LEN)
    return {
        'x_prompt': nrm(ks[0], (BATCH, SEQ, D_MODEL)),
        'x_sample': nrm(ks[1], (DEC_BATCH, DEC_SEQ, D_MODEL)),
        'state_conv_a': nrm(ks[2], (N_EVEN, DEC_BATCH, CONV_K - 1, A_WIDTH)),
        'cache_swa_k': nrm(ks[3], (N_EVEN, DEC_BATCH, win_buf, B_KV_HEADS, B_HEAD_DIM)),
        'cache_swa_v': nrm(ks[4], (N_EVEN, DEC_BATCH, win_buf, B_KV_HEADS, B_HEAD_DIM)),
        'state_hgrn': nrm(ks[5], (N_ODD, DEC_BATCH, C_HEADS, C_DK, C_DV), 0.3),
        'state_ffn_conv': nrm(ks[6], (DEPTH, DEC_BATCH, CONV_K - 1, D_FF), 0.5),
        'norm_mix_pre': 1.0 + nrm(ks[7], (DEPTH, D_MODEL), 0.02),
        'norm_mix_post': 1.0 + nrm(ks[8], (DEPTH, D_MODEL), 0.02),
        'norm_ffn_pre': 1.0 + nrm(ks[9], (DEPTH, D_MODEL), 0.02),
        'norm_ffn_post': 1.0 + nrm(ks[10], (DEPTH, D_MODEL), 0.02),
        'w_in_ab': nrm(ks[11], (N_EVEN, D_MODEL, D_IN_AB), D_MODEL ** -0.5),
        'conv_a_w': nrm(ks[12], (N_EVEN, CONV_K, A_WIDTH), CONV_K ** -0.5),
        'attn_sinks': nrm(ks[13], (N_EVEN, B_HEADS)),
        'w_out_ab': nrm(ks[14], (N_EVEN, D_MIX_AB, D_MODEL), D_MIX_AB ** -0.5),
        'w_in_c': nrm(ks[15], (N_ODD, D_MODEL, D_IN_C), D_MODEL ** -0.5),
        'hgrn_lb_logits': nrm(ks[16], (DEPTH, C_DK_T)),
        'hgrn_norm_g': 1.0 + nrm(ks[17], (N_ODD, C_DV), 0.02),
        'w_out_c': nrm(ks[18], (N_ODD, C_DV_T, D_MODEL), C_DV_T ** -0.5),
        'w_ffn_up': nrm(ks[19], (DEPTH, D_MODEL, 2 * D_FF), D_MODEL ** -0.5),
        'ffn_conv_w': nrm(ks[20], (DEPTH, CONV_K, D_FF), CONV_K ** -0.5),
        'w_ffn_down': nrm(ks[21], (DEPTH, D_FF, D_MODEL), D_FF ** -0.5),
    }


def reference(x_prompt, x_sample, state_conv_a, cache_swa_k, cache_swa_v, state_hgrn, state_ffn_conv,
              norm_mix_pre, norm_mix_post, norm_ffn_pre, norm_ffn_post, w_in_ab, conv_a_w, attn_sinks,
              w_out_ab, w_in_c, hgrn_lb_logits, hgrn_norm_g, w_out_c, w_ffn_up, ffn_conv_w, w_ffn_down):
    p = dict(norm_mix_pre=norm_mix_pre, norm_mix_post=norm_mix_post, norm_ffn_pre=norm_ffn_pre,
             norm_ffn_post=norm_ffn_post, w_in_ab=w_in_ab, conv_a_w=conv_a_w, attn_sinks=attn_sinks,
             w_out_ab=w_out_ab, w_in_c=w_in_c, hgrn_lb_logits=hgrn_lb_logits, hgrn_norm_g=hgrn_norm_g,
             w_out_c=w_out_c, w_ffn_up=w_ffn_up, ffn_conv_w=ffn_conv_w, w_ffn_down=w_ffn_down)
    Bp = x_prompt.shape[0]
    dt = x_prompt.dtype
    y_prompt, conv_p, k_p, v_p, hgrn_p, ffn_p = run_trunk(
        x_prompt,
        jnp.zeros((N_EVEN, Bp, CONV_K - 1, A_WIDTH), dt), None, None,
        jnp.zeros((N_ODD, Bp, C_HEADS, C_DK, C_DV), dt),
        jnp.zeros((DEPTH, Bp, CONV_K - 1, D_FF), dt), p)
    y_sample, conv_s, k_s, v_s, hgrn_s, ffn_s = run_trunk(
        x_sample, state_conv_a, cache_swa_k, cache_swa_v, state_hgrn, state_ffn_conv, p)
    return (y_prompt, y_sample, conv_p, conv_s, k_p, k_s, v_p, v_s, hgrn_p, hgrn_s, ffn_p, ffn_s)
```

```cpp
#include <hip/hip_runtime.h>
#include <cstdio>
#include <cstdint>

#ifndef MK_N_LAUNCHES
#define MK_N_LAUNCHES 1
#endif

namespace pg8 {
#define PG8_LAS __attribute__((address_space(3)))
typedef unsigned short bf16_t;
typedef short bf16x8 __attribute__((ext_vector_type(8)));
typedef float f32x4 __attribute__((ext_vector_type(4)));
typedef unsigned u32x4 __attribute__((ext_vector_type(4)));
constexpr int BM = 256, BK = 64, HALF = 128, HTB = HALF * BK * 2, STAGE_BYTES = 8 * HTB, NXCD = 8, WGM = 4;

__host__ __device__ __forceinline__ int lds_byte(int r, int c) { const int st = (r >> 4) * 2 + (c >> 5), rr = r & 15, cc = c & 31, ob = rr * 64 + cc * 2; return st * 1024 + (ob ^ (((ob >> 9) & 1) << 5)); }
__host__ __device__ __forceinline__ void stage_rc(int b, int& R, int& C) { const int st = b / 1024, sb = b % 1024, swz = sb ^ (((sb >> 9) & 1) << 5); R = (st >> 1) * 16 + swz / 64; C = (st & 1) * 32 + (swz % 64) / 2; }
__host__ __device__ __forceinline__ int perm32(int rho) { const int n = rho >> 4, i = rho & 15; return 8 * (i >> 2) + 4 * n + (i & 3); }

struct Unit { int pm, pn; };
struct Gemm { const bf16_t* A; const bf16_t* Bt; int M, N, K, lda; };

struct StaticOrder {
    int nM, nN, nwg, G, c;
    __host__ __device__ void init(int M, int N, int G_, int c_) { nM = M / BM; nN = N / BM; nwg = nM * nN; G = G_; c = c_; }
    __host__ __device__ bool next(int i, Unit& u) const {
        const long L = (long)i * G + c; if (L >= nwg) return false;
        int wgid = (int)L; { const int q = nwg / NXCD, r = nwg % NXCD, xcd = wgid % NXCD, off = wgid / NXCD; wgid = (xcd < r ? xcd * (q + 1) : r * (q + 1) + (xcd - r) * q) + off; }
        const int nig = WGM * nN, gid = wgid / nig, fm = gid * WGM, gsz = (nM - fm) < WGM ? (nM - fm) : WGM;
        u.pm = fm + ((wgid % nig) % gsz); u.pn = (wgid % nig) / gsz; return true;
    }
    __device__ __forceinline__ void a_ready(const Unit&) const {}
    __device__ __forceinline__ void done(const Unit&) const {}
};

__device__ __forceinline__ unsigned cvt_pk_bf16(float lo, float hi) { unsigned r; asm volatile("v_cvt_pk_bf16_f32 %0, %1, %2" : "=v"(r) : "v"(lo), "v"(hi)); return r; }

__device__ __forceinline__ float dpp_ror1(float v) { return __builtin_bit_cast(float, __builtin_amdgcn_mov_dpp(__builtin_bit_cast(int, v), 0x121, 0xf, 0xf, true)); }
__device__ __forceinline__ float dpp_ror2(float v) { return __builtin_bit_cast(float, __builtin_amdgcn_mov_dpp(__builtin_bit_cast(int, v), 0x122, 0xf, 0xf, true)); }
__device__ __forceinline__ float gelu_tanh_e(float y) { const float u = __builtin_fmaf(y * y, -0.10294324f, -2.3022082f); return y * __builtin_amdgcn_rcpf(1.0f + __builtin_amdgcn_exp2f(y * u)); }
struct EpiGen {
    static constexpr bool PERM = true, AFTER_DRAIN = false;
    bf16_t* O; int ldc; const float* lb; int lf_lo, lf_hi;
    int mode; const float* cw; float* halo; float* a01; float* b01; float* stout; PG8_LAS unsigned char* xb;
    const float* rs;
    __device__ __forceinline__ void operator()(f32x4 (&acc)[2][2][4][2], const Unit& u, int wr, int wc, int fr, int fq) const {
        if (rs) {
#pragma unroll
            for (int ai = 0; ai < 2; ++ai)
#pragma unroll
                for (int m = 0; m < 4; ++m) { const float r = rs[u.pm * BM + ai * HALF + wr * 64 + m * 16 + fr];
#pragma unroll
                    for (int bj = 0; bj < 2; ++bj)
#pragma unroll
                        for (int n = 0; n < 2; ++n) acc[ai][bj][m][n] = acc[ai][bj][m][n] * r; }
        }
        if (mode == 1) {
            constexpr int FF = 2816;
            const int cbase = u.pn * 128 + wc * 32 + 8 * fq;
            f32x4 w0[2], w1[2], w2[2];
#pragma unroll
            for (int n = 0; n < 2; ++n) { w0[n] = *(const f32x4*)(cw + cbase + 4 * n); w1[n] = *(const f32x4*)(cw + FF + cbase + 4 * n); w2[n] = *(const f32x4*)(cw + 2 * FF + cbase + 4 * n); }
            if (fr >= 14) {
#pragma unroll
                for (int ai = 0; ai < 2; ++ai)
#pragma unroll
                    for (int n = 0; n < 2; ++n) *(PG8_LAS f32x4*)(xb + ((((ai * 2 + wr) * 2 + (fr - 14)) * 128) + wc * 32 + 8 * fq + 4 * n) * 4) = acc[ai][0][3][n];
                if (wr == 1) {
#pragma unroll
                    for (int n = 0; n < 2; ++n) { *(f32x4*)(halo + (size_t)(u.pm * 2 + fr - 14) * FF + cbase + 4 * n) = acc[1][0][3][n];
                        if ((u.pm & 15) == 15) *(f32x4*)(stout + (size_t)((u.pm >> 4) * 2 + fr - 14) * FF + cbase + 4 * n) = acc[1][0][3][n]; }
                }
            }
            if (wr == 0 && fr < 2 && (u.pm & 15) != 0) {
#pragma unroll
                for (int n = 0; n < 2; ++n) { *(f32x4*)(a01 + (size_t)(u.pm * 2 + fr) * FF + cbase + 4 * n) = acc[0][0][0][n]; *(f32x4*)(b01 + (size_t)(u.pm * 2 + fr) * FF + cbase + 4 * n) = acc[0][1][0][n]; }
            }
            asm volatile("s_waitcnt lgkmcnt(0)" ::: "memory"); __builtin_amdgcn_s_barrier(); asm volatile("" ::: "memory");
#pragma unroll
            for (int ai = 0; ai < 2; ++ai) {
                f32x4 bnd[2] = {(f32x4){0.f, 0.f, 0.f, 0.f}, (f32x4){0.f, 0.f, 0.f, 0.f}};
                if (!(ai == 0 && wr == 0) && fr >= 14) {
                    const int sidx = (wr == 1) ? ai * 2 : (ai - 1) * 2 + 1;
#pragma unroll
                    for (int n = 0; n < 2; ++n) bnd[n] = *(const PG8_LAS f32x4*)(xb + (((sidx * 2 + (fr - 14)) * 128) + wc * 32 + 8 * fq + 4 * n) * 4);
                }
#pragma unroll
                for (int m = 0; m < 4; ++m) {
                    float g[8];
#pragma unroll
                    for (int n = 0; n < 2; ++n)
#pragma unroll
                        for (int i = 0; i < 4; ++i) {
                            const float cur = acc[ai][0][m][n][i];
                            const float pb = (m > 0) ? acc[ai][0][m > 0 ? m - 1 : 0][n][i] : bnd[n][i];
                            const float p1 = dpp_ror1(fr == 15 ? pb : cur), p2 = dpp_ror2(fr >= 14 ? pb : cur);
                            const float y = __builtin_fmaf(p2, w0[n][i], __builtin_fmaf(p1, w1[n][i], w2[n][i] * cur));
                            g[4 * n + i] = gelu_tanh_e(y) * acc[ai][1][m][n][i];
                        }
                    u32x4 w; w.x = cvt_pk_bf16(g[0], g[1]); w.y = cvt_pk_bf16(g[2], g[3]); w.z = cvt_pk_bf16(g[4], g[5]); w.w = cvt_pk_bf16(g[6], g[7]);
                    *(u32x4*)(O + (size_t)(u.pm * BM + ai * HALF + wr * 64 + m * 16 + fr) * FF + cbase) = w;
                }
            }
            return;
        }
        const int row0 = u.pm * BM + wr * 64 + fr; const int col0 = u.pn * BM + wc * 32 + 8 * fq;
        const bool tf = (u.pn >= lf_lo) && (u.pn < lf_hi);
        f32x4 lbv[2][2];
#pragma unroll
        for (int bj = 0; bj < 2; ++bj)
#pragma unroll
            for (int n = 0; n < 2; ++n) lbv[bj][n] = tf ? *(const f32x4*)(lb + (col0 - BM * lf_lo) + bj * HALF + 4 * n) : (f32x4){0.f, 0.f, 0.f, 0.f};
#pragma unroll
        for (int ai = 0; ai < 2; ++ai)
#pragma unroll
            for (int m = 0; m < 4; ++m) { bf16_t* rowp = O + (size_t)(row0 + ai * HALF + m * 16) * ldc + col0;
#pragma unroll
                for (int bj = 0; bj < 2; ++bj) { f32x4 v0 = acc[ai][bj][m][0], v1 = acc[ai][bj][m][1];
                    if (tf) {
#pragma unroll
                        for (int j = 0; j < 4; ++j) {
                            const float s0 = __builtin_amdgcn_rcpf(1.0f + __expf(-v0[j])), s1 = __builtin_amdgcn_rcpf(1.0f + __expf(-v1[j]));
                            v0[j] = __builtin_amdgcn_logf(lbv[bj][0][j] + (1.0f - lbv[bj][0][j]) * s0); v1[j] = __builtin_amdgcn_logf(lbv[bj][1][j] + (1.0f - lbv[bj][1][j]) * s1); } }
                    u32x4 w; w.x = cvt_pk_bf16(v0[0], v0[1]); w.y = cvt_pk_bf16(v0[2], v0[3]); w.z = cvt_pk_bf16(v1[0], v1[1]); w.w = cvt_pk_bf16(v1[2], v1[3]);
                    *(u32x4*)(rowp + bj * HALF) = w; } }
    }
};

template <class Epi, class Sched, bool ALIGN_EPI = false, bool SP2 = false>
__device__ __forceinline__ void gemm_phase(PG8_LAS unsigned char* lds, const Gemm g, const Sched& S, const Epi& E, const int tid) {
    const int wid = __builtin_amdgcn_readfirstlane(tid >> 6), lane = tid & 63, wr = wid >> 2, wc = wid & 3, fr = lane & 15, fq = lane >> 4;
    const int K = g.K, nt = K / BK, lda = g.lda;
    unsigned voffA[2], voffB[2];
#pragma unroll
    for (int i = 0; i < 2; ++i) { int R, C; stage_rc(tid * 16 + i * 8192, R, C); const int Rb = Epi::PERM ? ((R & ~31) + perm32(R & 31)) : R;
        voffA[i] = (unsigned)(R * lda + C) * 2u; voffB[i] = (unsigned)(Rb * K + C) * 2u; }
    const size_t kstep = (size_t)(BK * 2);
    const size_t hstepA = (size_t)HALF * lda * 2, hstepB = (size_t)HALF * K * 2;
    const size_t tstepA = 2 * hstepA, tstepB = 2 * hstepB;
    const unsigned ldsw = (unsigned)wid * 1024u;
    const int aoff = lds_byte(wr * 64 + fr, fq * 8), boff = lds_byte(wc * 32 + fr, fq * 8);
#define PG8_SA(b, h) (((b) * 2 + (h)) * HTB)
#define PG8_SB(b, h) ((4 + (b) * 2 + (h)) * HTB)
#define PG8_STAGE(bufoff, gbase, voff) do { _Pragma("unroll") for (int _i = 0; _i < 2; ++_i) \
        __builtin_amdgcn_global_load_lds((const unsigned*)((const char*)(gbase) + (voff)[_i]), (PG8_LAS unsigned*)(lds + (bufoff) + ldsw + _i * 8192), 16, 0, 0); } while (0)
#define PG8_LDA(dst, b, h) do { _Pragma("unroll") for (int m = 0; m < 4; ++m) _Pragma("unroll") for (int k = 0; k < 2; ++k) dst[m][k] = *(const PG8_LAS bf16x8*)(lds + PG8_SA(b, h) + aoff + m * 2048 + k * 1024); } while (0)
#define PG8_LDB(dst, b, h) do { _Pragma("unroll") for (int n = 0; n < 2; ++n) _Pragma("unroll") for (int k = 0; k < 2; ++k) dst[n][k] = *(const PG8_LAS bf16x8*)(lds + PG8_SB(b, h) + boff + n * 2048 + k * 1024); } while (0)
#define PG8_MMA(ai, bj, At, Bt) do { __builtin_amdgcn_s_setprio(1); _Pragma("unroll") for (int m = 0; m < 4; ++m) _Pragma("unroll") for (int n = 0; n < 2; ++n) _Pragma("unroll") for (int k = 0; k < 2; ++k) \
        acc[ai][bj][m][n] = __builtin_amdgcn_mfma_f32_16x16x32_bf16(Bt[n][k], At[m][k], acc[ai][bj][m][n], 0, 0, 0); __builtin_amdgcn_s_setprio(0); } while (0)
#define PG8_WAIT_V(n) asm volatile("s_waitcnt vmcnt(" #n ")" ::: "memory")
#define PG8_WAIT_L(n) asm volatile("s_waitcnt lgkmcnt(" #n ")" ::: "memory")
#define PG8_BAR __builtin_amdgcn_s_barrier()
#define PG8_SCHED __builtin_amdgcn_sched_barrier(0)
    Unit cur, nxt; int ui = 0;
    if (!S.next(0, cur)) return;
    f32x4 acc[2][2][4][2];
#pragma unroll
    for (int a = 0; a < 2; ++a)
#pragma unroll
        for (int b = 0; b < 2; ++b)
#pragma unroll
            for (int m = 0; m < 4; ++m)
#pragma unroll
                for (int n = 0; n < 2; ++n) acc[a][b][m][n] = (f32x4){0.f, 0.f, 0.f, 0.f};
    bf16x8 At[4][2], B0[2][2], B1[2][2];
    const char* cA = (const char*)g.A + (size_t)cur.pm * tstepA; const char* cB = (const char*)g.Bt + (size_t)cur.pn * tstepB;
    S.a_ready(cur);
    if constexpr (SP2) {
        PG8_STAGE(PG8_SB(0, 0), cB, voffB); PG8_STAGE(PG8_SB(0, 1), cB + hstepB, voffB); PG8_STAGE(PG8_SA(0, 0), cA, voffA); PG8_STAGE(PG8_SA(0, 1), cA + hstepA, voffA);
        if (wr == 1) PG8_BAR;
        PG8_WAIT_V(2); PG8_BAR;
        PG8_STAGE(PG8_SB(1, 0), cB + kstep, voffB); PG8_STAGE(PG8_SA(1, 0), cA + kstep, voffA); PG8_STAGE(PG8_SB(1, 1), cB + hstepB + kstep, voffB);
        PG8_WAIT_V(6); PG8_BAR;
    } else {
        PG8_STAGE(PG8_SB(0, 0), cB, voffB); PG8_STAGE(PG8_SA(0, 0), cA, voffA); PG8_STAGE(PG8_SB(0, 1), cB + hstepB, voffB); PG8_STAGE(PG8_SA(0, 1), cA + hstepA, voffA);
        if (wr == 1) PG8_BAR;
        PG8_WAIT_V(4); PG8_BAR;
        PG8_STAGE(PG8_SB(1, 0), cB + kstep, voffB); PG8_STAGE(PG8_SA(1, 0), cA + kstep, voffA); PG8_STAGE(PG8_SB(1, 1), cB + hstepB + kstep, voffB);
        PG8_WAIT_V(6); PG8_BAR;
    }
    for (;;) {
        const bool has_next = S.next(ui + 1, nxt);
        const char* nA = has_next ? (const char*)g.A + (size_t)nxt.pm * tstepA : cA; const char* nB = has_next ? (const char*)g.Bt + (size_t)nxt.pn * tstepB : cB;
        for (int t = 0; t < nt; t += 2) {
            const bool last = (t == nt - 2);
            const char* a1 = cA + (size_t)(t + 1) * kstep;
            const char* a2 = last ? nA : cA + (size_t)(t + 2) * kstep; const char* b2 = last ? nB : cB + (size_t)(t + 2) * kstep;
            const char* a3 = a2 + kstep; const char* b3 = b2 + kstep;
            if (last && has_next) S.a_ready(nxt);
            if constexpr (SP2) {
            PG8_LDB(B0, 0, 0); PG8_LDB(B1, 0, 1); PG8_SCHED; PG8_LDA(At, 0, 0); PG8_STAGE(PG8_SA(1, 1), a1 + hstepA, voffA);
            PG8_WAIT_V(8); PG8_WAIT_L(0); PG8_BAR; PG8_MMA(0, 0, At, B0); PG8_MMA(0, 1, At, B1); PG8_BAR; PG8_SCHED;
            PG8_LDA(At, 0, 1); PG8_STAGE(PG8_SB(0, 0), b2, voffB); PG8_STAGE(PG8_SB(0, 1), b2 + hstepB, voffB); PG8_STAGE(PG8_SA(0, 0), a2, voffA);
            PG8_WAIT_V(8); PG8_WAIT_L(0); PG8_BAR; PG8_MMA(1, 0, At, B0); PG8_MMA(1, 1, At, B1); PG8_BAR; PG8_SCHED;
            PG8_LDB(B0, 1, 0); PG8_LDB(B1, 1, 1); PG8_SCHED; PG8_LDA(At, 1, 0); PG8_STAGE(PG8_SA(0, 1), a2 + hstepA, voffA);
            PG8_WAIT_V(8); PG8_WAIT_L(0); PG8_BAR; PG8_MMA(0, 0, At, B0); PG8_MMA(0, 1, At, B1); PG8_BAR; PG8_SCHED;
            PG8_LDA(At, 1, 1); PG8_STAGE(PG8_SB(1, 0), b3, voffB); PG8_STAGE(PG8_SB(1, 1), b3 + hstepB, voffB); PG8_STAGE(PG8_SA(1, 0), a3, voffA);
            PG8_WAIT_V(8); PG8_WAIT_L(0); PG8_BAR; PG8_MMA(1, 0, At, B0); PG8_MMA(1, 1, At, B1); PG8_BAR; PG8_SCHED;
            } else {
            PG8_LDB(B0, 0, 0); PG8_SCHED; PG8_LDA(At, 0, 0); PG8_STAGE(PG8_SA(1, 1), a1 + hstepA, voffA);
            PG8_WAIT_L(8); PG8_BAR; PG8_WAIT_L(0); PG8_MMA(0, 0, At, B0); PG8_BAR; PG8_SCHED;
            PG8_LDB(B1, 0, 1); PG8_STAGE(PG8_SB(0, 0), b2, voffB);
            PG8_BAR; PG8_WAIT_L(0); PG8_MMA(0, 1, At, B1); PG8_BAR;
            PG8_LDA(At, 0, 1); PG8_STAGE(PG8_SA(0, 0), a2, voffA);
            PG8_BAR; PG8_WAIT_L(0); PG8_MMA(1, 0, At, B0); PG8_BAR; PG8_SCHED;
            PG8_STAGE(PG8_SB(0, 1), b2 + hstepB, voffB);
            PG8_WAIT_V(6); PG8_BAR; PG8_MMA(1, 1, At, B1); PG8_BAR;
            PG8_LDB(B0, 1, 0); PG8_SCHED; PG8_LDA(At, 1, 0); PG8_STAGE(PG8_SA(0, 1), a2 + hstepA, voffA);
            PG8_WAIT_L(8); PG8_BAR; PG8_WAIT_L(0); PG8_MMA(0, 0, At, B0); PG8_BAR; PG8_SCHED;
            PG8_LDB(B1, 1, 1); PG8_STAGE(PG8_SB(1, 0), b3, voffB);
            PG8_BAR; PG8_WAIT_L(0); PG8_MMA(0, 1, At, B1); PG8_BAR;
            PG8_LDA(At, 1, 1); PG8_STAGE(PG8_SA(1, 0), a3, voffA);
            PG8_BAR; PG8_WAIT_L(0); PG8_MMA(1, 0, At, B0); PG8_BAR; PG8_SCHED;
            PG8_STAGE(PG8_SB(1, 1), b3 + hstepB, voffB);
            PG8_WAIT_V(6); PG8_BAR; PG8_MMA(1, 1, At, B1); PG8_BAR;
            }
        }
        if constexpr (ALIGN_EPI) { if (wr == 0) PG8_BAR; }
        if constexpr (!Epi::AFTER_DRAIN) { E(acc, cur, wr, wc, fr, fq); S.done(cur); }
        if (!has_next) break;
#pragma unroll
        for (int a = 0; a < 2; ++a)
#pragma unroll
            for (int b = 0; b < 2; ++b)
#pragma unroll
                for (int m = 0; m < 4; ++m)
#pragma unroll
                    for (int n = 0; n < 2; ++n) acc[a][b][m][n] = (f32x4){0.f, 0.f, 0.f, 0.f};
        cur = nxt; cA = nA; cB = nB; ++ui;
        if constexpr (ALIGN_EPI) { if (wr == 1) PG8_BAR; }
    }
    PG8_WAIT_V(0);
    if constexpr (!ALIGN_EPI) { if (wr == 0) PG8_BAR; }
    PG8_BAR;
#undef PG8_SA
#undef PG8_SB
#undef PG8_STAGE
#undef PG8_LDA
#undef PG8_LDB
#undef PG8_MMA
#undef PG8_WAIT_V
#undef PG8_WAIT_L
#undef PG8_BAR
#undef PG8_SCHED
}
}

constexpr int NWAVES = 8;
constexpr int N_LAUNCHES = MK_N_LAUNCHES;
constexpr int N_PHASES = 18;
constexpr int D = 1024, BATCH = 8, SEQ = 4096, NB = 128, NS = 4;
constexpr int MP = BATCH * SEQ, MS = NB * NS, MT = MP + MS;
constexpr int AW = 512, NKV = 2, HD = 64, WIN = 128;
constexpr int DINAB = 2304, DINC = 4096, DFF = 2816, DUP = 5632;
constexpr int CH = 8, CDK = 128, CDV = 128, GCH = 64;
constexpr float EPS = 1e-6f;
constexpr float LOG2E = 1.4426950408889634f;
constexpr int C_H = 0, C_GB = 512, C_GC = 1024, C_Q = 1536, C_K = 2048, C_V = 2176;
constexpr int C1_Q = 0, C1_F = 1024, C1_I = 2048, C1_G = 3072;

constexpr size_t O_Y = 0;
constexpr size_t O_CAP = (size_t)MT * D;
constexpr size_t O_CAS = O_CAP + (size_t)BATCH * 2 * AW;
constexpr size_t O_KP = O_CAS + (size_t)NB * 2 * AW;
constexpr size_t O_KS = O_KP + (size_t)BATCH * WIN * NKV * HD;
constexpr size_t O_VP = O_KS + (size_t)NB * WIN * NKV * HD;
constexpr size_t O_VS = O_VP + (size_t)BATCH * WIN * NKV * HD;
constexpr size_t O_HP = O_VS + (size_t)NB * WIN * NKV * HD;
constexpr size_t O_HS = O_HP + (size_t)BATCH * CH * CDK * CDV;
constexpr size_t O_FP = O_HS + (size_t)NB * CH * CDK * CDV;
constexpr size_t O_FS = O_FP + (size_t)2 * BATCH * 2 * DFF;
constexpr size_t O_END = O_FS + (size_t)2 * NB * 2 * DFF;
static_assert(O_END == 58032128, "output size");

constexpr size_t MiB = 1u << 20;
constexpr size_t WS_CTL = 0, CTL_ZERO_BYTES = 1 * MiB;
constexpr size_t WS_LB = 1 * MiB;
constexpr size_t WS_RS = 1 * MiB + 64 * 1024;
constexpr size_t W_INAB = 2 * MiB;
constexpr size_t W_OUTAB = W_INAB + (size_t)DINAB * D * 2;
constexpr size_t W_INC = W_OUTAB + (size_t)D * D * 2;
constexpr size_t W_OUTC = W_INC + (size_t)DINC * D * 2;
constexpr size_t W_UP0 = W_OUTC + (size_t)D * D * 2;
constexpr size_t W_UP1 = W_UP0 + (size_t)DUP * D * 2;
constexpr size_t W_DN0 = W_UP1 + (size_t)DUP * D * 2;
constexpr size_t W_DN1 = W_DN0 + (size_t)D * DFF * 2;
constexpr size_t W_END = W_DN1 + (size_t)D * DFF * 2;
constexpr size_t WS_ACT1 = 54 * MiB;
constexpr size_t WS_XB = 119 * MiB;
constexpr size_t WS_BR = 184 * MiB;
constexpr size_t WS_MIX = WS_BR;
constexpr size_t WS_END = WS_BR + (size_t)MT * DINC * 2;
static_assert(W_END <= WS_ACT1 && WS_ACT1 + (size_t)MT * D * 2 <= WS_XB && WS_XB + (size_t)MT * D * 2 <= WS_BR && WS_END <= 512 * MiB && WS_RS + (size_t)MT * 4 <= 2 * MiB, "ws map");
constexpr int NSEG = 4, SEGL = SEQ / NSEG, NGI = BATCH * CH * NSEG;
constexpr size_t OQ_QSEG = 0;
constexpr size_t OQ_OLOC = OQ_QSEG + 48 * MiB;
constexpr size_t OQ_DS = OQ_OLOC + 48 * MiB;
constexpr size_t OQ_DD = OQ_DS + (size_t)NGI * CDK * CDV * 4;
constexpr size_t OQ_EACC = OQ_DD + 256 * 1024;
static_assert(OQ_EACC + (size_t)NGI * 16 * CDK * 4 <= (size_t)MT * D * 4, "GLA scratch fits the y region of d_out");
constexpr size_t WS_HALO = WS_BR + 182 * MiB, WS_A01 = WS_HALO + 3 * MiB, WS_B01 = WS_A01 + 3 * MiB;
static_assert((size_t)128 * 2 * DFF * 4 <= 3 * MiB && WS_BR + (size_t)MT * DFF * 2 <= WS_HALO && WS_B01 + 3 * MiB <= WS_END, "ws map 4");
constexpr int XB_OFF = 131072;
constexpr int CW_BAR = 4096;

constexpr int LDS_BYTES = 147456;
constexpr int LDSCTL_OFF = 143360, MISC_OFF = LDSCTL_OFF + 320;

#define GAS __attribute__((address_space(1)))
#define LAS __attribute__((address_space(3)))
typedef unsigned short bf16;
typedef unsigned v4u __attribute__((ext_vector_type(4)));
typedef unsigned v2u __attribute__((ext_vector_type(2)));
typedef float f32x4 __attribute__((ext_vector_type(4)));
typedef float f32x16 __attribute__((ext_vector_type(16)));
typedef short bf16x8 __attribute__((ext_vector_type(8)));
typedef GAS unsigned gu32;
#define RLX_AGENT __ATOMIC_RELAXED, __HIP_MEMORY_SCOPE_AGENT
#define LDS_WAIT() asm volatile("s_waitcnt lgkmcnt(0)" ::: "memory")
typedef float f32x2_t __attribute__((ext_vector_type(2))); typedef __bf16 bf16x2_t __attribute__((ext_vector_type(2)));
__device__ __forceinline__ unsigned pk2(float lo, float hi) { f32x2_t v = {lo, hi}; bf16x2_t b = __builtin_convertvector(v, bf16x2_t); return __builtin_bit_cast(unsigned, b); }
__device__ __forceinline__ unsigned f2bf(float f) { __bf16 b = (__bf16)f; return (unsigned)__builtin_bit_cast(unsigned short, b); }
__device__ __forceinline__ float bflo(unsigned w) { return __builtin_bit_cast(float, w << 16); }
__device__ __forceinline__ float bfhi(unsigned w) { return __builtin_bit_cast(float, w & 0xffff0000u); }
__device__ __forceinline__ float bf2f(unsigned short b) { return __builtin_bit_cast(float, ((unsigned)b) << 16); }
__device__ __forceinline__ float ex2(float x) { return __builtin_amdgcn_exp2f(x); }
__device__ __forceinline__ float fexp(float x) { return __builtin_amdgcn_exp2f(x * LOG2E); }

#define XB_TMO      128
#define XB_XCNT(j)  (256  + 64 * (j))
#define XB_XSUB(j)  (1280 + 64 * (j))
#define XB_XGEN(j)  (2304 + 64 * (j))
#define XB_TOP      3328
#define XB_TOPGEN   3392
#define XCD_BAR_WORDS 3456
#define XB_SPIN_CAP (1u << 18)
__device__ __forceinline__ unsigned xb_ld(unsigned* p)              { return __hip_atomic_load(p, __ATOMIC_RELAXED, __HIP_MEMORY_SCOPE_AGENT); }
__device__ __forceinline__ unsigned xb_add(unsigned* p, unsigned v) { return __hip_atomic_fetch_add(p, v, __ATOMIC_RELAXED, __HIP_MEMORY_SCOPE_AGENT); }
__device__ __forceinline__ unsigned xb_xcc_id() { return (unsigned)__builtin_amdgcn_s_getreg((3 << 11) | 20) & 0xFu; }
#define XB_SPIN(cond, bar) do { unsigned _sp = 0; while (cond) { __builtin_amdgcn_s_sleep(1); \
    if ((++_sp & 255u) == 0u) { if (xb_ld(&(bar)[XB_TMO])) break; if (_sp > XB_SPIN_CAP) { atomicAdd(&(bar)[XB_TMO], 1u); break; } } } } while (0)
struct XcdBarrier { unsigned* bar; unsigned x; volatile LAS unsigned* st; };
__device__ __forceinline__ XcdBarrier xcd_barrier_post(unsigned* bar, volatile LAS unsigned* st) {
    XcdBarrier b; b.bar = bar; b.x = xb_xcc_id(); b.st = st;
    if (threadIdx.x == 0) (void)xb_add(&bar[XB_XCNT(b.x)], 1u);
    return b;
}
__device__ __forceinline__ void xcd_barrier_complete(unsigned* bar, unsigned x, unsigned& nloc, unsigned& nx) {
    const unsigned G = gridDim.x * gridDim.y * gridDim.z;
    unsigned sum, cnt, mine, sp = 0u;
    for (;;) {
        sum = 0u; cnt = 0u; mine = 0u;
#pragma unroll
        for (unsigned j = 0; j < 16; ++j) { const unsigned c = xb_ld(&bar[XB_XCNT(j)]); sum += c; cnt += (c > 0u) ? 1u : 0u; mine = (j == x) ? c : mine; }
        if (sum == G) break;
        __builtin_amdgcn_s_sleep(1);
        if ((++sp & 255u) == 0u) { if (xb_ld(&bar[XB_TMO])) break; if (sp > XB_SPIN_CAP) { atomicAdd(&bar[XB_TMO], 1u); break; } }
    }
    nloc = mine > 0u ? mine : 1u; nx = cnt > 0u ? cnt : 1u;
}
__device__ __forceinline__ void xcd_barrier(const XcdBarrier& b) {
    asm volatile("s_waitcnt vmcnt(0)" ::: "memory");
    __syncthreads();
    if (threadIdx.x == 0) {
        unsigned* bar = b.bar;
        __builtin_amdgcn_s_waitcnt(0);
        unsigned nloc = b.st[0], nx = b.st[1];
        if (nloc == 0u) { xcd_barrier_complete(bar, b.x, nloc, nx); b.st[0] = nloc; b.st[1] = nx; }
        const unsigned old = xb_add(&bar[XB_XSUB(b.x)], 1u);
        const unsigned gen = old / nloc;
        if (old + 1u == (gen + 1u) * nloc) {
            __builtin_amdgcn_fence(__ATOMIC_RELEASE, "agent");
            asm volatile("s_waitcnt vmcnt(0)" ::: "memory");
            const unsigned og = xb_add(&bar[XB_TOP], 1u);
            const unsigned tg = og / nx;
            if (og + 1u == (tg + 1u) * nx) xb_add(&bar[XB_TOPGEN], 1u);
            else XB_SPIN(xb_ld(&bar[XB_TOPGEN]) == tg, bar);
            __builtin_amdgcn_fence(__ATOMIC_ACQUIRE, "agent");
            xb_add(&bar[XB_XGEN(b.x)], 1u);
            asm volatile("s_waitcnt vmcnt(0)" ::: "memory");
        } else {
            XB_SPIN(xb_ld(&bar[XB_XGEN(b.x)]) == gen, bar);
            __builtin_amdgcn_fence(__ATOMIC_ACQUIRE, "agent");
            asm volatile("s_waitcnt vmcnt(0)" ::: "memory");
        }
    }
    __syncthreads();
}

__device__ __forceinline__ float shx(float v, int o, int lane) { return __builtin_bit_cast(float, __builtin_amdgcn_ds_bpermute((lane ^ o) << 2, __builtin_bit_cast(int, v))); }
__device__ __forceinline__ float wave_sum(float v, int lane) {
#pragma unroll
    for (int o = 1; o < 64; o <<= 1) v += shx(v, o, lane);
    return v;
}
struct Ctx {
    LAS unsigned char* lds;
    int tid, lane, wave, vcu, G;
    const float* in[22];
    float* out;
    unsigned char* ws;
};

__device__ __forceinline__ Ctx reopaque(const Ctx& F) { Ctx G = F; int l; asm volatile("v_mbcnt_lo_u32_b32 %0, -1, 0\n\tv_mbcnt_hi_u32_b32 %0, -1, %0" : "=v"(l)); G.lane = l; G.tid = F.wave * 64 + l; return G; }

struct TrItem { const float* W; bf16* WT; const float* gain; int K, N, item, perm; };
__device__ __forceinline__ TrItem tr_decode(const Ctx& F, int it) {
    constexpr int I_INAB = (D / 64) * (DINAB / 32), I_SQ = (D / 64) * (D / 32), I_INC = (D / 64) * (DINC / 32), I_UP = (D / 64) * (DUP / 32), I_DN = (DFF / 64) * (D / 32);
    TrItem t; int r = it; t.gain = nullptr; t.perm = 0; t.K = D;
    if (r < I_INAB) { t.W = F.in[11]; t.N = DINAB; t.WT = (bf16*)(F.ws + W_INAB); t.gain = F.in[7]; t.item = r; return t; } r -= I_INAB;
    if (r < I_SQ) { t.W = F.in[14]; t.N = D; t.WT = (bf16*)(F.ws + W_OUTAB); t.item = r; return t; } r -= I_SQ;
    if (r < I_INC) { t.W = F.in[15]; t.N = DINC; t.WT = (bf16*)(F.ws + W_INC); t.gain = F.in[7] + D; t.item = r; return t; } r -= I_INC;
    if (r < I_SQ) { t.W = F.in[18]; t.N = D; t.WT = (bf16*)(F.ws + W_OUTC); t.item = r; return t; } r -= I_SQ;
    if (r < I_UP) { t.W = F.in[19]; t.N = DUP; t.WT = (bf16*)(F.ws + W_UP0); t.gain = F.in[9]; t.perm = 1; t.item = r; return t; } r -= I_UP;
    if (r < I_UP) { t.W = F.in[19] + (size_t)D * DUP; t.N = DUP; t.WT = (bf16*)(F.ws + W_UP1); t.gain = F.in[9] + D; t.perm = 1; t.item = r; return t; } r -= I_UP;
    t.K = DFF; t.N = D;
    if (r < I_DN) { t.W = F.in[21]; t.WT = (bf16*)(F.ws + W_DN0); t.item = r; return t; } r -= I_DN;
    t.W = F.in[21] + (size_t)DFF * D; t.WT = (bf16*)(F.ws + W_DN1); t.item = r; return t;
}
__device__ __forceinline__ void tr_load(const TrItem& t, int lane, f32x4 (&v)[8], float (&gg)[8]) {
    const int nblk = t.N / 32, kb = t.item / nblk, nb = t.item - kb * nblk, k0 = 64 * kb, n0 = 32 * nb;
#pragma unroll
    for (int i = 0; i < 8; ++i) { const int kk = 8 * i + (lane >> 3); v[i] = *(const f32x4*)(t.W + (size_t)(k0 + kk) * t.N + n0 + 4 * (lane & 7)); gg[i] = t.gain ? t.gain[k0 + kk] : 1.0f; }
}
__device__ __forceinline__ void tr_store(const TrItem& t, int lane, const f32x4 (&v)[8], const float (&gg)[8], LAS float* scr) {
    const int nblk = t.N / 32, kb = t.item / nblk, nb = t.item - kb * nblk, k0 = 64 * kb, n0 = 32 * nb;
    const int d0 = t.perm ? ((n0 < DFF) ? (256 * (n0 >> 7) + (n0 & 127)) : (256 * ((n0 - DFF) >> 7) + 128 + ((n0 - DFF) & 127))) : n0;
#pragma unroll
    for (int i = 0; i < 8; ++i) { LAS float* dd = scr + (8 * i + (lane >> 3)) * 33 + 4 * (lane & 7); dd[0] = v[i].x * gg[i]; dd[1] = v[i].y * gg[i]; dd[2] = v[i].z * gg[i]; dd[3] = v[i].w * gg[i]; }
    LDS_WAIT(); asm volatile("" ::: "memory");
    const int c = lane & 7;
#pragma unroll
    for (int j = 0; j < 4; ++j) { const int n = (lane >> 3) + 8 * j; const LAS float* s = scr + (8 * c) * 33 + n;
        v4u o; o.x = pk2(s[0 * 33], s[1 * 33]); o.y = pk2(s[2 * 33], s[3 * 33]); o.z = pk2(s[4 * 33], s[5 * 33]); o.w = pk2(s[6 * 33], s[7 * 33]);
        *(GAS v4u*)(t.WT + (size_t)(d0 + n) * t.K + k0 + 8 * c) = o; }
    LDS_WAIT(); asm volatile("" ::: "memory");
}

__device__ __forceinline__ void phase_prologue(const Ctx& F) {
    LAS float* scr = (LAS float*)(F.lds + F.wave * 16384);
    const int gw = F.vcu * NWAVES + F.wave, NGW = F.G * NWAVES;
    constexpr int I_INAB = (D / 64) * (DINAB / 32), I_SQ = (D / 64) * (D / 32), I_INC = (D / 64) * (DINC / 32), I_UP = (D / 64) * (DUP / 32), I_DN = (DFF / 64) * (D / 32);
    constexpr int NITEMS = I_INAB + 2 * I_SQ + I_INC + 2 * I_UP + 2 * I_DN;
    if (gw < NITEMS) {
        f32x4 v[8]; float gg[8];
        TrItem cur = tr_decode(F, gw); tr_load(cur, F.lane, v, gg);
        for (int it = gw; it < NITEMS; it += NGW) {
            const int itn = (it + NGW < NITEMS) ? it + NGW : it;
            const TrItem nxt = tr_decode(F, itn);
            f32x4 vn[8]; float gn[8];
            tr_load(nxt, F.lane, vn, gn);
            tr_store(cur, F.lane, v, gg, scr);
            cur = nxt;
#pragma unroll
            for (int i = 0; i < 8; ++i) { v[i] = vn[i]; gg[i] = gn[i]; }
        }
    }
    { bf16* XB = (bf16*)(F.ws + WS_XB); float* RS = (float*)(F.ws + WS_RS); const int lane = F.lane;
      f32x4 xq[3][4];
#define P0_LOAD(slot, mm) do { const int m_ = (mm) < MT ? (mm) : MT - 1; const float* xr_ = m_ < MP ? F.in[0] + (size_t)m_ * D : F.in[1] + (size_t)(m_ - MP) * D; \
        _Pragma("unroll") for (int j = 0; j < 4; ++j) xq[slot][j] = ((const f32x4*)xr_)[64 * j + lane]; } while (0)
      P0_LOAD(0, gw); P0_LOAD(1, gw + NGW);
      for (int m = gw; m < MT; m += NGW) {
          P0_LOAD(2, m + 2 * NGW);
          float s = 0.f;
          unsigned long long* o8 = (unsigned long long*)(XB + (size_t)m * D) + lane;
#pragma unroll
          for (int j = 0; j < 4; ++j) { const f32x4 x = xq[0][j]; s += (x.x * x.x + x.y * x.y) + (x.z * x.z + x.w * x.w);
              o8[64 * j] = (unsigned long long)pk2(x.x, x.y) | ((unsigned long long)pk2(x.z, x.w) << 32); }
          const float r = __builtin_amdgcn_rsqf(wave_sum(s, lane) * (1.f / D) + EPS);
          if (lane == 0) RS[m] = r;
#pragma unroll
          for (int j = 0; j < 4; ++j) { xq[0][j] = xq[1][j]; xq[1][j] = xq[2][j]; }
      }
#undef P0_LOAD
    }
    float* LB = (float*)(F.ws + WS_LB);
    for (int i = F.vcu * 512 + F.tid; i < CH * CDK; i += F.G * 512) {
        const float l0 = F.in[16][i], l1 = F.in[16][CH * CDK + i];
        float p = 1.0f / (1.0f + __expf(l0 - l1));
        LB[i] = fminf(fmaxf(p, 0.f), 1.f);
    }
}

__device__ __forceinline__ void conva_rows(const bf16* PROJ, bf16* MIXED, const float* cw, size_t row0, int nrows, bool have_prev, const float* prev_state, float* state_out, int lane) {
    const int c = lane * 8;
    float w0[8], w1[8], w2[8], um2[8], um1[8];
#pragma unroll
    for (int i = 0; i < 8; ++i) { w0[i] = cw[c + i]; w1[i] = cw[AW + c + i]; w2[i] = cw[2 * AW + c + i]; um2[i] = 0.f; um1[i] = 0.f; }
    if (prev_state) {
#pragma unroll
        for (int i = 0; i < 8; ++i) { um2[i] = prev_state[c + i]; um1[i] = prev_state[AW + c + i]; }
    } else if (have_prev) {
        const v4u h2 = *(const v4u*)(PROJ + (row0 - 2) * DINAB + C_H + c), g2 = *(const v4u*)(PROJ + (row0 - 2) * DINAB + C_GC + c);
        const v4u h1 = *(const v4u*)(PROJ + (row0 - 1) * DINAB + C_H + c), g1 = *(const v4u*)(PROJ + (row0 - 1) * DINAB + C_GC + c);
#pragma unroll
        for (int i = 0; i < 4; ++i) { um2[2 * i] = bflo(h2[i]) * bflo(g2[i]); um2[2 * i + 1] = bfhi(h2[i]) * bfhi(g2[i]); um1[2 * i] = bflo(h1[i]) * bflo(g1[i]); um1[2 * i + 1] = bfhi(h1[i]) * bfhi(g1[i]); }
    }
    const char* pb = (const char*)(PROJ + row0 * DINAB + c);
    char* ob = (char*)(MIXED + row0 * D + c);
    v4u hv[4], gbv[4], gcv[4];
#pragma unroll
    for (int p = 0; p < 4; ++p) { const char* pr = pb + (size_t)p * DINAB * 2; hv[p] = *(const v4u*)(pr + C_H * 2); gbv[p] = *(const v4u*)(pr + C_GB * 2); gcv[p] = *(const v4u*)(pr + C_GC * 2); }
    for (int r4 = 0; r4 < nrows; r4 += 4) {
        v4u hn[4], gbn[4], gcn[4];
        { const int rn = (r4 + 4 < nrows) ? r4 + 4 : r4;
#pragma unroll
          for (int p = 0; p < 4; ++p) { const char* pr = pb + (size_t)(rn + p) * DINAB * 2; hn[p] = *(const v4u*)(pr + C_H * 2); gbn[p] = *(const v4u*)(pr + C_GB * 2); gcn[p] = *(const v4u*)(pr + C_GC * 2); } }
#pragma unroll
        for (int p = 0; p < 4; ++p) {
            float u[8], y[8];
#pragma unroll
            for (int i = 0; i < 4; ++i) { u[2 * i] = bflo(hv[p][i]) * bflo(gcv[p][i]); u[2 * i + 1] = bfhi(hv[p][i]) * bfhi(gcv[p][i]); }
#pragma unroll
            for (int i = 0; i < 8; ++i) y[i] = w0[i] * um2[i] + w1[i] * um1[i] + w2[i] * u[i];
            v4u o;
#pragma unroll
            for (int i = 0; i < 4; ++i) o[i] = pk2(bflo(gbv[p][i]) * y[2 * i], bfhi(gbv[p][i]) * y[2 * i + 1]);
            *(v4u*)(ob + (size_t)(r4 + p) * D * 2) = o;
#pragma unroll
            for (int i = 0; i < 8; ++i) { um2[i] = um1[i]; um1[i] = u[i]; }
        }
#pragma unroll
        for (int p = 0; p < 4; ++p) { hv[p] = hn[p]; gbv[p] = gbn[p]; gcv[p] = gcn[p]; }
    }
    if (state_out) {
#pragma unroll
        for (int i = 0; i < 8; ++i) { state_out[c + i] = um2[i]; state_out[AW + c + i] = um1[i]; }
    }
}

constexpr int AT_KS = 0, AT_VT = 36864, AT_LINV = AT_VT + 33792, AT_OST = AT_LINV + 1024;
__device__ __forceinline__ void attn_prompt_unit(const Ctx& F, const bf16* PROJ, bf16* MIXED, int u) {
    const int tid = F.tid, lane = F.lane, wave = F.wave;
    const int kvh = u & 1, qb = (u >> 1) & 31, b = u >> 6;
    const long rowq0 = (long)b * SEQ + (long)qb * 128;
    LAS unsigned char* Ks = F.lds + AT_KS;
    LAS unsigned char* Vt = F.lds + AT_VT;
    LAS float* linv = (LAS float*)(F.lds + AT_LINV) + wave * 32;
    { unsigned z = 0u; asm volatile("" : "+v"(z));
      const char* kbase = (const char*)PROJ + ((rowq0 - 128) * DINAB + C_K + kvh * HD) * 2;
      const unsigned koff = (unsigned)(((tid >> 3) * DINAB + (tid & 7) * 8) * 2);
#pragma unroll
      for (int i = 0; i < 4; ++i) {
        v4u val = (v4u){z, z, z, z};
        if (qb > 0 || i >= 2) val = *(const v4u*)(kbase + (long)i * 64 * DINAB * 2 + koff);
        *(LAS v4u*)(Ks + ((tid >> 3) + 64 * i) * 144 + (tid & 7) * 16) = val;
      }
      const char* vbase = (const char*)PROJ + ((rowq0 - 128) * DINAB + C_V + kvh * HD) * 2;
      const unsigned voff = (unsigned)(((tid & 255) * DINAB + (tid >> 8) * 8) * 2);
      const int key = tid & 255;
#pragma unroll
      for (int i = 0; i < 4; ++i) {
        v4u val = (v4u){z, z, z, z};
        if (qb > 0 || key >= 128) val = *(const v4u*)(vbase + i * 32 + voff);
        const int dc = (tid >> 8) + 2 * i;
#pragma unroll
        for (int j = 0; j < 8; ++j) *(LAS unsigned short*)(Vt + (dc * 8 + j) * 528 + key * 2) = (unsigned short)(val[j >> 1] >> (16 * (j & 1)));
      }
    }
    __syncthreads();
    const int g = wave >> 1, qhalf = wave & 1, head = kvh * 4 + g;
    const float slope2 = ex2(-(float)(head + 1)) * LOG2E, sink2 = F.in[13][head] * LOG2E, sc2 = 0.125f * LOG2E;
    const int qi = lane & 31, hi = lane >> 5;
#pragma unroll 1
    for (int qblk = 0; qblk < 2; ++qblk) {
        const int q0 = qhalf * 64 + qblk * 32;
        const char* qbase = (const char*)PROJ + ((rowq0 + q0) * DINAB + C_Q + head * HD) * 2;
        const unsigned qoff = (unsigned)((qi * DINAB + 8 * hi) * 2);
        bf16x8 qf[4];
#pragma unroll
        for (int ks = 0; ks < 4; ++ks) qf[ks] = *(const bf16x8*)(qbase + ks * 32 + qoff);
        f32x16 o0 = {0.f, 0.f, 0.f, 0.f, 0.f, 0.f, 0.f, 0.f, 0.f, 0.f, 0.f, 0.f, 0.f, 0.f, 0.f, 0.f}, o1 = o0;
        float mx = sink2, l = 0.f;
#pragma unroll 1
        for (int kt = 0; kt < 5; ++kt) {
            f32x16 st = {0.f, 0.f, 0.f, 0.f, 0.f, 0.f, 0.f, 0.f, 0.f, 0.f, 0.f, 0.f, 0.f, 0.f, 0.f, 0.f};
            const LAS unsigned char* kp = Ks + (q0 + 32 * kt + qi) * 144 + 16 * hi;
#pragma unroll
            for (int ks = 0; ks < 4; ++ks) {
                const bf16x8 kf = *(const LAS bf16x8*)(kp + 32 * ks);
                st = __builtin_amdgcn_mfma_f32_32x32x16_bf16(kf, qf[ks], st, 0, 0, 0);
            }
            float tmx = mx;
#pragma unroll
            for (int r = 0; r < 16; ++r) {
                const int crow = (r & 3) + 8 * (r >> 2) + 4 * hi;
                const int dist = 128 + qi - 32 * kt - crow;
                const bool valid = (dist >= 0) && (dist < WIN) && (qb > 0 || (q0 + 32 * kt + crow) >= 128);
                const float x = valid ? (st[r] * sc2 - slope2 * (float)dist) : -INFINITY;
                st[r] = x; tmx = fmaxf(tmx, x);
            }
            tmx = fmaxf(tmx, shx(tmx, 32, lane));
            const float alpha = ex2(mx - tmx); mx = tmx;
            linv[qi] = alpha;
            LDS_WAIT();
            float ps = 0.f;
#pragma unroll
            for (int r = 0; r < 16; ++r) { const float p = ex2(st[r] - mx); st[r] = p; ps += p; }
            ps += shx(ps, 32, lane);
            l = l * alpha + ps;
#pragma unroll
            for (int r = 0; r < 16; ++r) { const float al = linv[(r & 3) + 8 * (r >> 2) + 4 * hi]; o0[r] *= al; o1[r] *= al; }
            LDS_WAIT();
#pragma unroll
            for (int s = 0; s < 2; ++s) {
                v4u pw;
#pragma unroll
                for (int j = 0; j < 4; ++j) pw[j] = pk2(st[8 * s + 2 * j], st[8 * s + 2 * j + 1]);
                const bf16x8 pa = __builtin_bit_cast(bf16x8, pw);
                const LAS unsigned char* vp = Vt + qi * 528 + (q0 + 32 * kt + 16 * s + 4 * hi) * 2;
                const v2u a0 = *(const LAS v2u*)(vp), a1 = *(const LAS v2u*)(vp + 16);
                const v2u b0 = *(const LAS v2u*)(vp + 32 * 528), b1 = *(const LAS v2u*)(vp + 32 * 528 + 16);
                const bf16x8 vb0 = __builtin_bit_cast(bf16x8, (v4u){a0.x, a0.y, a1.x, a1.y});
                const bf16x8 vb1 = __builtin_bit_cast(bf16x8, (v4u){b0.x, b0.y, b1.x, b1.y});
                o0 = __builtin_amdgcn_mfma_f32_32x32x16_bf16(pa, vb0, o0, 0, 0, 0);
                o1 = __builtin_amdgcn_mfma_f32_32x32x16_bf16(pa, vb1, o1, 0, 0, 0);
            }
        }
        l += ex2(sink2 - mx);
        linv[qi] = 1.0f / l;
        LDS_WAIT();
        LAS unsigned char* ost = F.lds + AT_OST + wave * 4608;
#pragma unroll
        for (int r = 0; r < 16; ++r) {
            const int crow = (r & 3) + 8 * (r >> 2) + 4 * hi;
            const float li = linv[crow];
            *(LAS unsigned short*)(ost + crow * 144 + qi * 2) = (unsigned short)f2bf(o0[r] * li);
            *(LAS unsigned short*)(ost + crow * 144 + 64 + qi * 2) = (unsigned short)f2bf(o1[r] * li);
        }
        LDS_WAIT();
        { const int orow = lane >> 1, ohalf = lane & 1;
          char* op = (char*)MIXED + ((rowq0 + q0 + orow) * D + AW + head * HD + 32 * ohalf) * 2;
#pragma unroll
          for (int j = 0; j < 4; ++j) *(v4u*)(op + 16 * j) = *(const LAS v4u*)(ost + orow * 144 + 64 * ohalf + 16 * j); }
        LDS_WAIT();
    }
    __syncthreads();
}

constexpr int SA_KS = 68;
constexpr int SA_K = 0, SA_V = SA_K + 132 * SA_KS * 4, SA_Q = SA_V + 132 * 64 * 4, SA_P = SA_Q + 16 * 64 * 4, SA_PS = 136, SA_O = SA_P + 16 * SA_PS * 4;
__device__ __forceinline__ void attn_sample_item(const Ctx& F, const bf16* PROJ, bf16* MIXED, int item) {
    const int tid = F.tid, lane = F.lane, wave = F.wave;
    const int s = item >> 1, kvh = item & 1;
    const size_t rs = (size_t)MP + (size_t)s * NS;
    LAS float* Kc = (LAS float*)(F.lds + SA_K); LAS float* Vc = (LAS float*)(F.lds + SA_V); LAS float* Qs = (LAS float*)(F.lds + SA_Q); LAS float* P = (LAS float*)(F.lds + SA_P); LAS float* Op = (LAS float*)(F.lds + SA_O);
    const float* ck = F.in[3] + (size_t)s * WIN * NKV * HD + kvh * HD; const float* cv = F.in[4] + (size_t)s * WIN * NKV * HD + kvh * HD;
    float* ok = F.out + O_KS + (size_t)s * WIN * NKV * HD + kvh * HD; float* ov = F.out + O_VS + (size_t)s * WIN * NKV * HD + kvh * HD;
#pragma unroll
    for (int i = 0; i < 4; ++i) {
        const int idx = tid + 512 * i, j = idx >> 4, d4 = idx & 15;
        const f32x4 kk = *(const f32x4*)(ck + (size_t)j * NKV * HD + 4 * d4), vv = *(const f32x4*)(cv + (size_t)j * NKV * HD + 4 * d4);
        *(LAS f32x4*)(Kc + j * SA_KS + 4 * d4) = kk; *(LAS f32x4*)(Vc + j * 64 + 4 * d4) = vv;
        if (j >= NS) { *(f32x4*)(ok + (size_t)(j - NS) * NKV * HD + 4 * d4) = kk; *(f32x4*)(ov + (size_t)(j - NS) * NKV * HD + 4 * d4) = vv; }
    }
    if (tid < 256) {
        const int t = tid >> 6, d = tid & 63;
        const float kk = bf2f(PROJ[(rs + t) * DINAB + C_K + kvh * HD + d]), vv = bf2f(PROJ[(rs + t) * DINAB + C_V + kvh * HD + d]);
        Kc[(WIN + t) * SA_KS + d] = kk; Vc[(WIN + t) * 64 + d] = vv;
        ok[(size_t)(WIN - NS + t) * NKV * HD + d] = kk; ov[(size_t)(WIN - NS + t) * NKV * HD + d] = vv;
    }
    for (int idx = tid; idx < 16 * 64; idx += 512) {
        const int r = idx >> 6, d = idx & 63, g = r >> 2, t = r & 3;
        Qs[idx] = bf2f(PROJ[(rs + t) * DINAB + C_Q + (kvh * 4 + g) * HD + d]);
    }
    __syncthreads();
    for (int p = tid; p < 16 * 132; p += 512) {
        const int r = p / 132, j = p - r * 132, g = r >> 2, t = r & 3;
        const int dist = WIN + t - j;
        float acc = 0.f;
#pragma unroll
        for (int d4 = 0; d4 < 16; ++d4) { const f32x4 q4 = *(const LAS f32x4*)(Qs + r * 64 + 4 * d4), k4 = *(const LAS f32x4*)(Kc + j * SA_KS + 4 * d4); acc += (q4.x * k4.x + q4.y * k4.y) + (q4.z * k4.z + q4.w * k4.w); }
        const float slope = ex2(-(float)(kvh * 4 + g + 1));
        P[r * SA_PS + j] = (dist >= 0 && dist < WIN) ? (acc * 0.125f - slope * (float)dist) : -INFINITY;
    }
    __syncthreads();
#pragma unroll
    for (int rr = 0; rr < 2; ++rr) {
        const int r = wave * 2 + rr, g = r >> 2;
        const float sink = F.in[13][kvh * 4 + g];
        float v0 = P[r * SA_PS + lane], v1 = P[r * SA_PS + 64 + lane], v2 = lane < 4 ? P[r * SA_PS + 128 + lane] : -INFINITY;
        float mx = fmaxf(fmaxf(v0, v1), fmaxf(v2, sink));
#pragma unroll
        for (int o = 1; o < 64; o <<= 1) mx = fmaxf(mx, shx(mx, o, lane));
        v0 = fexp(v0 - mx); v1 = fexp(v1 - mx); v2 = fexp(v2 - mx);
        const float den = wave_sum(v0 + v1 + v2, lane) + fexp(sink - mx);
        const float inv = 1.0f / den;
        P[r * SA_PS + lane] = v0 * inv; P[r * SA_PS + 64 + lane] = v1 * inv; if (lane < 4) P[r * SA_PS + 128 + lane] = v2 * inv;
    }
    __syncthreads();
    {
      const int jh = tid >> 8, r = (tid >> 4) & 15, d4 = tid & 15;
      f32x4 acc = {0.f, 0.f, 0.f, 0.f};
#pragma unroll 6
      for (int jj = 0; jj < 66; ++jj) { const int j = jh * 66 + jj; const float pw = P[r * SA_PS + j]; const f32x4 v4 = *(const LAS f32x4*)(Vc + j * 64 + 4 * d4); acc = acc + v4 * pw; }
      if (jh == 1) *(LAS f32x4*)(Op + r * 64 + 4 * d4) = acc;
      __syncthreads();
      if (jh == 0) {
          const f32x4 o2 = *(const LAS f32x4*)(Op + r * 64 + 4 * d4); acc = acc + o2;
          const int g = r >> 2, t = r & 3;
          *(v2u*)(MIXED + (rs + t) * D + AW + (kvh * 4 + g) * HD + 4 * d4) = (v2u){pk2(acc.x, acc.y), pk2(acc.z, acc.w)};
      }
    }
    __syncthreads();
}

__device__ __forceinline__ void phase_mixer_ab(const Ctx& F0) {
    const bf16* PROJ = (const bf16*)(F0.ws + WS_BR); bf16* MIXED = (bf16*)(F0.ws + WS_ACT1);
    for (int u = F0.vcu; u < BATCH * 32 * NKV; u += F0.G) attn_prompt_unit(F0, PROJ, MIXED, u);
    const Ctx F1 = reopaque(F0);
    for (int it = F1.vcu; it < NB * NKV; it += F1.G) attn_sample_item(F1, PROJ, MIXED, it);
    const Ctx F = reopaque(F1);
    const int gw = F.vcu * NWAVES + F.wave, NGW = F.G * NWAVES;
    for (int it = gw; it < MP / 16; it += NGW) {
        const int b = it >> 8, r0 = (it & 255) * 16;
        conva_rows(PROJ, MIXED, F.in[12], (size_t)b * SEQ + r0, 16, r0 > 0, nullptr, r0 == SEQ - 16 ? F.out + O_CAP + (size_t)b * 2 * AW : nullptr, F.lane);
    }
    for (int it = gw; it < NB; it += NGW)
        conva_rows(PROJ, MIXED, F.in[12], (size_t)MP + (size_t)it * NS, NS, false, F.in[2] + (size_t)it * 2 * AW, F.out + O_CAS + (size_t)it * 2 * AW, F.lane);
    for (int i = F.vcu * 512 + F.tid; i < 2 * BATCH * WIN * NKV * HD; i += F.G * 512) {
        const int which = i / (BATCH * WIN * NKV * HD), e = i - which * (BATCH * WIN * NKV * HD);
        const int b = e / (WIN * NKV * HD), rem = e - b * (WIN * NKV * HD), j = rem / (NKV * HD), c = rem - j * (NKV * HD);
        const float v = bf2f(PROJ[((size_t)b * SEQ + SEQ - WIN + j) * DINAB + (which ? C_V : C_K) + c]);
        F.out[(which ? O_VP : O_KP) + e] = v;
    }
}

template <int MODE>
__device__ __forceinline__ void phase_rowwise(const Ctx& F, const bf16* src, const float* gpost) {
    const int gw = F.vcu * NWAVES + F.wave, NGW = F.G * NWAVES, lane = F.lane;
    bf16* XB = (bf16*)(F.ws + WS_XB); float* RS = (float*)(F.ws + WS_RS);
    f32x4 gp[4];
#pragma unroll
    for (int j = 0; j < 4; ++j) gp[j] = ((const f32x4*)gpost)[64 * j + lane];
    v2u sw[3][4]; f32x4 xf[3][4]; v2u xw[3][4];
#define RW_LOAD(slot, mm) do { const int m_ = (mm) < MT ? (mm) : MT - 1; const float* xr_ = m_ < MP ? F.in[0] + (size_t)m_ * D : F.in[1] + (size_t)(m_ - MP) * D; \
        _Pragma("unroll") for (int j = 0; j < 4; ++j) { sw[slot][j] = ((const v2u*)(src + (size_t)m_ * D))[64 * j + lane]; \
            if (MODE == 0) xf[slot][j] = ((const f32x4*)xr_)[64 * j + lane]; else xw[slot][j] = ((const v2u*)(XB + (size_t)m_ * D))[64 * j + lane]; } } while (0)
    RW_LOAD(0, gw); RW_LOAD(1, gw + NGW);
    for (int m = gw; m < MT; m += NGW) {
        RW_LOAD(2, m + 2 * NGW);
        f32x4 v[4], xv[4]; float s = 0.f;
#pragma unroll
        for (int j = 0; j < 4; ++j) { v[j] = (f32x4){bflo(sw[0][j].x), bfhi(sw[0][j].x), bflo(sw[0][j].y), bfhi(sw[0][j].y)};
            xv[j] = (MODE == 0) ? xf[0][j] : (f32x4){bflo(xw[0][j].x), bfhi(xw[0][j].x), bflo(xw[0][j].y), bfhi(xw[0][j].y)};
            s += (v[j].x * v[j].x + v[j].y * v[j].y) + (v[j].z * v[j].z + v[j].w * v[j].w); }
        const float r = __builtin_amdgcn_rsqf(wave_sum(s, lane) * (1.f / D) + EPS);
        float s2 = 0.f;
#pragma unroll
        for (int j = 0; j < 4; ++j) {
            xv[j] = xv[j] + v[j] * r * gp[j]; s2 += (xv[j].x * xv[j].x + xv[j].y * xv[j].y) + (xv[j].z * xv[j].z + xv[j].w * xv[j].w);
            if (MODE == 2) ((f32x4*)(F.out + (size_t)m * D))[64 * j + lane] = xv[j];
            else ((unsigned long long*)(XB + (size_t)m * D))[64 * j + lane] = (unsigned long long)pk2(xv[j].x, xv[j].y) | ((unsigned long long)pk2(xv[j].z, xv[j].w) << 32); }
        if (MODE != 2) { const float r2 = __builtin_amdgcn_rsqf(wave_sum(s2, lane) * (1.f / D) + EPS); if (lane == 0) RS[m] = r2; }
#pragma unroll
        for (int j = 0; j < 4; ++j) { sw[0][j] = sw[1][j]; sw[1][j] = sw[2][j];
            if (MODE == 0) { xf[0][j] = xf[1][j]; xf[1][j] = xf[2][j]; } else { xw[0][j] = xw[1][j]; xw[1][j] = xw[2][j]; } }
    }
#undef RW_LOAD
}

__device__ __forceinline__ float gelu_tanh(float y) {
    const float z2 = 1.5957691216057308f * (y + 0.044715f * y * y * y);
    return y * __builtin_amdgcn_rcpf(1.0f + fexp(-z2));
}
__device__ __forceinline__ void phase_ffnfix(const Ctx& F, int layer) {
    bf16* G = (bf16*)(F.ws + WS_BR);
    const float* cw = F.in[20] + (size_t)layer * 3 * DFF;
    const float* HALO = (const float*)(F.ws + WS_HALO); const float* A01 = (const float*)(F.ws + WS_A01); const float* B01 = (const float*)(F.ws + WS_B01);
    for (int idx = F.vcu * 512 + F.tid; idx < 120 * DFF; idx += F.G * 512) {
        const int t = idx / DFF, c = idx - t * DFF, pm = (t / 15) * 16 + 1 + (t % 15);
        const float h0 = HALO[(size_t)((pm - 1) * 2) * DFF + c], h1 = HALO[(size_t)((pm - 1) * 2 + 1) * DFF + c];
        const float a0 = A01[(size_t)(pm * 2) * DFF + c], a1 = A01[(size_t)(pm * 2 + 1) * DFF + c];
        const float b0 = B01[(size_t)(pm * 2) * DFF + c], b1 = B01[(size_t)(pm * 2 + 1) * DFF + c];
        const float w0 = cw[c], w1 = cw[DFF + c], w2 = cw[2 * DFF + c];
        G[(size_t)(pm * 256) * DFF + c] = (bf16)f2bf(gelu_tanh(w0 * h0 + w1 * h1 + w2 * a0) * b0);
        G[(size_t)(pm * 256 + 1) * DFF + c] = (bf16)f2bf(gelu_tanh(w0 * h1 + w1 * a0 + w2 * a1) * b1);
    }
}

constexpr int GL_QT = 0, GL_KD = 17408, GL_Q0 = 34816, GL_KO = 43520, GL_KHT = 52224, GL_VT = 70656, GL_AM = 89088, GL_ST = 98304, GL_TX = 133120, GL_DEC = 135168, GL_END = 135680;
constexpr int GL_OS = 0;
static_assert(GL_END <= LDSCTL_OFF, "GLA LDS map");
__device__ __forceinline__ void gla_finish_row(const f32x4 (&ov)[4], const v4u gate0, const v4u gate1, const float (&gn)[16], char* op, int lane) {
    float ss = 0.f;
#pragma unroll
    for (int j = 0; j < 4; ++j) ss += (ov[j].x * ov[j].x + ov[j].y * ov[j].y) + (ov[j].z * ov[j].z + ov[j].w * ov[j].w);
    ss += shx(ss, 1, lane); ss += shx(ss, 2, lane); ss += shx(ss, 4, lane);
    const float rn = __builtin_amdgcn_rsqf(ss * (1.f / CDV) + EPS);
    const unsigned gw_[8] = {gate0.x, gate0.y, gate0.z, gate0.w, gate1.x, gate1.y, gate1.z, gate1.w};
    unsigned ow[8];
#pragma unroll
    for (int j = 0; j < 8; ++j) {
        const float g0 = bflo(gw_[j]), g1 = bfhi(gw_[j]);
        const float s0 = g0 * __builtin_amdgcn_rcpf(1.0f + fexp(-g0)), s1 = g1 * __builtin_amdgcn_rcpf(1.0f + fexp(-g1));
        const float n0 = gn[2 * j], n1 = gn[2 * j + 1];
        ow[j] = pk2(ov[j >> 1][(2 * j) & 3] * rn * n0 * s0, ov[j >> 1][(2 * j + 1) & 3] * rn * n1 * s1);
    }
    *(v4u*)op = (v4u){ow[0], ow[1], ow[2], ow[3]}; *(v4u*)(op + 16) = (v4u){ow[4], ow[5], ow[6], ow[7]};
}
__device__ __forceinline__ void gla_prompt_item(const Ctx& F, const bf16* PROJ, bf16* OUT, int item) {
    int lane = F.lane; asm volatile("" : "+v"(lane));
    const int wave = F.wave, tid = wave * 64 + lane;
    const int b = item >> 5, h = (item >> 2) & 7, seg = item & 3;
    LAS unsigned char* L = F.lds;
    const int d = tid & 127, qi = tid >> 7;
    const int l31 = lane & 31, hi = lane >> 5, l15 = lane & 15, l4 = lane >> 4;
    { unsigned z = 0u; asm volatile("" : "+v"(z));
      for (int i = tid; i < (GL_ST + 34816 - GL_AM) / 16; i += 512) *(LAS v4u*)(L + GL_AM + i * 16) = (v4u){z, z, z, z}; }
    f32x16 Sa = {0.f, 0.f, 0.f, 0.f, 0.f, 0.f, 0.f, 0.f, 0.f, 0.f, 0.f, 0.f, 0.f, 0.f, 0.f, 0.f}, Sb = Sa;
    const int vi = wave & 3, dkA = 2 * (wave >> 2), ti2 = wave >> 2;
    const float* gnorm = F.in[17];
    const long rowb = (long)b * SEQ + (long)seg * SEGL;
    const long crowb = (long)b * 3 * SEGL + (long)(seg - 1) * SEGL;
    const char* pbase = (const char*)PROJ + (rowb * DINC + h * CDK) * 2;
    const __amdgpu_buffer_rsrc_t prs = __builtin_amdgcn_make_buffer_rsrc((void*)pbase, 0, 0x7fffffff, 0x00020000);
    const __amdgpu_buffer_rsrc_t qrs = __builtin_amdgcn_make_buffer_rsrc((void*)((char*)F.out + OQ_QSEG + (crowb * D + h * CDK) * 2), 0, seg > 0 ? SEGL * D * 2 : 0, 0x00020000);
    const int ctok = tid >> 4, cdc = tid & 15;
    const int cvoff = (ctok * DINC + cdc * 8) * 2, cloff = ctok * 272 + cdc * 16;
    constexpr int GL_RAW = GL_Q0;
    v4u R[3][2];
#pragma unroll
    for (int T = 0; T < 3; ++T)
#pragma unroll
        for (int p = 0; p < 2; ++p) R[T][p] = __builtin_bit_cast(v4u, __builtin_amdgcn_raw_buffer_load_b128(prs, cvoff, (p * 32 * DINC + T * 1024) * 2, 0));
    const int et = tid >> 3, eseg = tid & 7;
    float gn[16];
#pragma unroll
    for (int j = 0; j < 16; ++j) gn[j] = gnorm[16 * eseg + j];
    const int goff = (et * DINC + 16 * eseg) * 2; const unsigned ooff = (unsigned)((et * D + 16 * eseg) * 2);
    float Gacc = 0.f;
    float* eacc = (float*)((char*)F.out + OQ_EACC) + (size_t)item * 16 * CDK;
    __syncthreads();
    for (int c = 0; c < SEGL / GCH; ++c) {
#pragma unroll
        for (int T = 0; T < 3; ++T)
#pragma unroll
            for (int p = 0; p < 2; ++p) *(LAS v4u*)(L + GL_RAW + T * 17408 + p * 32 * 272 + cloff) = R[T][p];
        __syncthreads();
        unsigned short qv[16], lv[16], vv[16];
#pragma unroll
        for (int t = 0; t < 16; ++t) { const LAS unsigned char* rp = L + GL_RAW + (16 * qi + t) * 272 + d * 2;
            qv[t] = *(const LAS unsigned short*)rp; lv[t] = *(const LAS unsigned short*)(rp + 17408); vv[t] = *(const LAS unsigned short*)(rp + 2 * 17408); }
        float cs[16];
        { float run = 0.f;
#pragma unroll
          for (int t = 0; t < 16; ++t) { run += bf2f(lv[t]); cs[t] = run; } }
        ((LAS float*)(L + GL_TX))[qi * 128 + d] = cs[15];
        __syncthreads();
        const float T0 = ((LAS float*)(L + GL_TX))[d], T1 = ((LAS float*)(L + GL_TX))[128 + d], T2 = ((LAS float*)(L + GL_TX))[256 + d], T3 = ((LAS float*)(L + GL_TX))[384 + d];
        const float B1 = T0 + T1, Gend = B1 + T2 + T3;
        const float base32 = (qi >= 2) ? B1 : 0.f;
        const float add16 = (qi == 1) ? T0 : ((qi == 3) ? T2 : 0.f);
        { v4u kh[2], vt[2];
          const float EB1 = ex2(B1), EGR = ex2(Gend - base32);
          LAS unsigned char* xdst = (qi >= 2) ? (L + GL_Q0 + (16 * qi - 32) * 272 + d * 2) : (L + GL_KO + (16 * qi) * 272 + d * 2);
#pragma unroll
          for (int t = 0; t < 16; ++t) {
            const float c32 = fmaxf(cs[t] + add16, -115.f);
            const float q = bf2f(qv[t]), k = 1.0f - ex2(bf2f(lv[t]));
            const float e1 = ex2(c32), e1i = __builtin_amdgcn_rcpf(e1);
            const float qt = q * e1, kd = k * e1i;
            const int row = 16 * qi + t;
            *(LAS unsigned short*)(L + GL_QT + row * 272 + d * 2) = (unsigned short)f2bf(qt);
            *(LAS unsigned short*)(L + GL_KD + row * 272 + d * 2) = (unsigned short)f2bf(kd);
            *(LAS unsigned short*)(xdst + t * 272) = (unsigned short)f2bf(((qi >= 2) ? qt : kd) * EB1);
            const unsigned khb = f2bf(kd * EGR);
            if (t & 1) { kh[t >> 3][(t & 7) >> 1] |= khb << 16; vt[t >> 3][(t & 7) >> 1] |= ((unsigned)vv[t]) << 16; }
            else       { kh[t >> 3][(t & 7) >> 1] = khb;        vt[t >> 3][(t & 7) >> 1] = (unsigned)vv[t]; }
            if ((t & 3) == 3) __builtin_amdgcn_sched_barrier(0);
          }
          *(LAS v4u*)(L + GL_KHT + d * 144 + (16 * qi) * 2) = kh[0]; *(LAS v4u*)(L + GL_KHT + d * 144 + (16 * qi + 8) * 2) = kh[1];
          *(LAS v4u*)(L + GL_VT + d * 144 + (16 * qi) * 2) = vt[0];  *(LAS v4u*)(L + GL_VT + d * 144 + (16 * qi + 8) * 2) = vt[1];
          if (qi == 0) { ((LAS float*)(L + GL_DEC))[d] = ex2(Gend); eacc[c * CDK + d] = ex2(Gacc); }
          Gacc += Gend;
        }
        { const int cn = (c + 1 < SEGL / GCH) ? c + 1 : c;
#pragma unroll
          for (int T = 0; T < 3; ++T)
#pragma unroll
              for (int p = 0; p < 2; ++p) R[T][p] = __builtin_bit_cast(v4u, __builtin_amdgcn_raw_buffer_load_b128(prs, cvoff, ((cn * GCH + p * 32) * DINC + T * 1024) * 2, 0)); }
        const v4u gate0 = __builtin_bit_cast(v4u, __builtin_amdgcn_raw_buffer_load_b128(prs, goff, (c * GCH * DINC + C1_G) * 2, 0));
        const v4u gate1 = __builtin_bit_cast(v4u, __builtin_amdgcn_raw_buffer_load_b128(prs, goff, (c * GCH * DINC + C1_G) * 2 + 16, 0));
        __syncthreads();
#pragma unroll
        for (int p = 0; p < 2; ++p) {
            const v4u qw = *(const LAS v4u*)(L + (p ? GL_Q0 : GL_QT) + cloff);
            __builtin_amdgcn_raw_buffer_store_b128(__builtin_bit_cast(__attribute__((__vector_size__(4 * sizeof(unsigned)))) unsigned, qw), qrs, (ctok * D + cdc * 8) * 2, ((c * GCH + p * 32) * D) * 2, 0);
        }
#pragma unroll
        for (int rep = 0; rep < 2; ++rep) {
            const int idx = wave + 8 * rep;
            if (idx < 10) {
                const int ti = idx < 1 ? 0 : (idx < 3 ? 1 : (idx < 6 ? 2 : 3));
                const int sj = idx - (ti * (ti + 1)) / 2;
                const bool same = (ti >> 1) == (sj >> 1);
                LAS unsigned char* kbse = same ? (L + GL_KD) : (L + GL_KO);
                f32x4 a = {0.f, 0.f, 0.f, 0.f};
#pragma unroll
                for (int ks = 0; ks < 4; ++ks) {
                    const bf16x8 af = *(const LAS bf16x8*)(L + GL_QT + (16 * ti + l15) * 272 + (32 * ks + 8 * l4) * 2);
                    const bf16x8 bf = *(const LAS bf16x8*)(kbse + (16 * sj + l15) * 272 + (32 * ks + 8 * l4) * 2);
                    a = __builtin_amdgcn_mfma_f32_16x16x32_bf16(af, bf, a, 0, 0, 0);
                }
#pragma unroll
                for (int r = 0; r < 4; ++r) {
                    const int tl = 4 * l4 + r;
                    const float v = (ti != sj || l15 <= tl) ? a[r] : 0.f;
                    *(LAS unsigned short*)(L + GL_AM + (16 * ti + tl) * 144 + (16 * sj + l15) * 2) = (unsigned short)f2bf(v);
                }
            }
        }
        __syncthreads();
        f32x16 o = {0.f, 0.f, 0.f, 0.f, 0.f, 0.f, 0.f, 0.f, 0.f, 0.f, 0.f, 0.f, 0.f, 0.f, 0.f, 0.f};
        bf16x8 vf[4];
#pragma unroll
        for (int ks = 0; ks < 4; ++ks) vf[ks] = *(const LAS bf16x8*)(L + GL_VT + (32 * vi + l31) * 144 + (16 * ks + 8 * hi) * 2);
#pragma unroll
        for (int ks = 0; ks < 4; ++ks) {
            const bf16x8 af = *(const LAS bf16x8*)(L + GL_AM + (32 * ti2 + l31) * 144 + (16 * ks + 8 * hi) * 2);
            o = __builtin_amdgcn_mfma_f32_32x32x16_bf16(af, vf[ks], o, 0, 0, 0);
        }
        { LAS unsigned char* qbase = ti2 ? (L + GL_Q0) : (L + GL_QT);
#pragma unroll
          for (int ks = 0; ks < 8; ++ks) {
            const bf16x8 af = *(const LAS bf16x8*)(qbase + l31 * 272 + (16 * ks + 8 * hi) * 2);
            const bf16x8 sf = *(const LAS bf16x8*)(L + GL_ST + (32 * vi + l31) * 272 + (16 * ks + 8 * hi) * 2);
            o = __builtin_amdgcn_mfma_f32_32x32x16_bf16(af, sf, o, 0, 0, 0);
          } }
#pragma unroll
        for (int r = 0; r < 16; ++r) {
            const int crow = (r & 3) + 8 * (r >> 2) + 4 * hi;
            Sa[r] *= ((LAS float*)(L + GL_DEC))[32 * dkA + crow]; Sb[r] *= ((LAS float*)(L + GL_DEC))[32 * dkA + 32 + crow];
        }
#pragma unroll
        for (int ks = 0; ks < 4; ++ks) {
            const bf16x8 ka = *(const LAS bf16x8*)(L + GL_KHT + (32 * dkA + l31) * 144 + (16 * ks + 8 * hi) * 2);
            const bf16x8 kb = *(const LAS bf16x8*)(L + GL_KHT + (32 * dkA + 32 + l31) * 144 + (16 * ks + 8 * hi) * 2);
            Sa = __builtin_amdgcn_mfma_f32_32x32x16_bf16(ka, vf[ks], Sa, 0, 0, 0);
            Sb = __builtin_amdgcn_mfma_f32_32x32x16_bf16(kb, vf[ks], Sb, 0, 0, 0);
        }
        __syncthreads();
#pragma unroll
        for (int g4 = 0; g4 < 4; ++g4) {
            *(LAS v2u*)(L + GL_ST + (32 * vi + l31) * 272 + (32 * dkA + 8 * g4 + 4 * hi) * 2) = (v2u){pk2(Sa[4 * g4], Sa[4 * g4 + 1]), pk2(Sa[4 * g4 + 2], Sa[4 * g4 + 3])};
            *(LAS v2u*)(L + GL_ST + (32 * vi + l31) * 272 + (32 * dkA + 32 + 8 * g4 + 4 * hi) * 2) = (v2u){pk2(Sb[4 * g4], Sb[4 * g4 + 1]), pk2(Sb[4 * g4 + 2], Sb[4 * g4 + 3])};
        }
#pragma unroll
        for (int r = 0; r < 16; ++r) {
            const int crow = (r & 3) + 8 * (r >> 2) + 4 * hi;
            ((LAS float*)(L + GL_OS))[(32 * ti2 + crow) * 132 + 32 * vi + l31] = o[r];
        }
        __syncthreads();
        { const LAS f32x4* orow = (const LAS f32x4*)(L + GL_OS + (et * 132 + 16 * eseg) * 4);
          f32x4 ov[4];
#pragma unroll
          for (int j = 0; j < 4; ++j) ov[j] = orow[j];
          if (seg == 0) gla_finish_row(ov, gate0, gate1, gn, (char*)OUT + ((rowb + (long)c * GCH) * D + h * CDV) * 2 + ooff, lane);
          else { char* op = (char*)F.out + OQ_OLOC + ((crowb + (long)c * GCH) * D + h * CDV) * 2 + ooff;
                 *(v4u*)op = (v4u){pk2(ov[0].x, ov[0].y), pk2(ov[0].z, ov[0].w), pk2(ov[1].x, ov[1].y), pk2(ov[1].z, ov[1].w)};
                 *(v4u*)(op + 16) = (v4u){pk2(ov[2].x, ov[2].y), pk2(ov[2].z, ov[2].w), pk2(ov[3].x, ov[3].y), pk2(ov[3].z, ov[3].w)}; }
        }
    }
    char* so = (char*)F.out + OQ_DS + ((size_t)item * CDK * CDV + (size_t)(32 * dkA) * CDV + 32 * vi) * 4;
    unsigned soff = (unsigned)((4 * hi * CDV + l31) * 4);
    asm volatile("" : "+v"(soff));
#pragma unroll
    for (int r = 0; r < 16; ++r) {
        const int crow0 = (r & 3) + 8 * (r >> 2);
        *(float*)(so + crow0 * CDV * 4 + soff) = Sa[r];
        *(float*)(so + (32 + crow0) * CDV * 4 + soff) = Sb[r];
    }
    if (qi == 0) ((float*)((char*)F.out + OQ_DD))[item * CDK + d] = ex2(Gacc);
    __syncthreads();
}

__device__ __forceinline__ void gla_fix_item(const Ctx& F, const bf16* PROJ, bf16* OUT, int item3) {
    const int tid = F.tid, lane = F.lane, wave = F.wave;
    const int bh = item3 / 3, seg = 1 + item3 - bh * 3, b = bh >> 3, h = bh & 7;
    LAS unsigned char* L = F.lds;
    const int l31 = lane & 31, hi = lane >> 5;
    const float* DS = (const float*)((const char*)F.out + OQ_DS); const float* DD = (const float*)((const char*)F.out + OQ_DD);
    const int dvt = tid & 127, dq = wave >> 1;
    float S[32];
#pragma unroll
    for (int i = 0; i < 32; ++i) S[i] = 0.f;
    for (int j = 0; j < seg; ++j) {
        const __amdgpu_buffer_rsrc_t rs = __builtin_amdgcn_make_buffer_rsrc((void*)(DS + (size_t)(bh * NSEG + j) * CDK * CDV), 0, CDK * CDV * 4, 0x00020000);
        const float* dd = DD + (bh * NSEG + j) * CDK + 32 * dq;
#pragma unroll
        for (int i = 0; i < 32; ++i) S[i] = dd[i] * S[i] + __builtin_bit_cast(float, __builtin_amdgcn_raw_buffer_load_b32(rs, dvt * 4, (32 * dq + i) * CDV * 4, 0));
    }
    if (seg == NSEG - 1) {
        const __amdgpu_buffer_rsrc_t rs = __builtin_amdgcn_make_buffer_rsrc((void*)(DS + (size_t)(bh * NSEG + seg) * CDK * CDV), 0, CDK * CDV * 4, 0x00020000);
        const __amdgpu_buffer_rsrc_t ro = __builtin_amdgcn_make_buffer_rsrc((void*)(F.out + O_HP + (size_t)bh * CDK * CDV), 0, CDK * CDV * 4, 0x00020000);
        const float* dd = DD + (bh * NSEG + seg) * CDK + 32 * dq;
#pragma unroll
        for (int i = 0; i < 32; ++i) {
            const float v = dd[i] * S[i] + __builtin_bit_cast(float, __builtin_amdgcn_raw_buffer_load_b32(rs, dvt * 4, (32 * dq + i) * CDV * 4, 0));
            __builtin_amdgcn_raw_buffer_store_b32(__builtin_bit_cast(unsigned, v), ro, dvt * 4, (32 * dq + i) * CDV * 4, 0);
        }
    }
    const int vi = wave & 3, ti2 = wave >> 2, et = tid >> 3, eseg = tid & 7;
    const long rowb = (long)b * SEQ + (long)seg * SEGL, crowb = (long)b * 3 * SEGL + (long)(seg - 1) * SEGL;
    const float* gnorm = F.in[17];
    const float* eacc = (const float*)((const char*)F.out + OQ_EACC) + (size_t)(bh * NSEG + seg) * 16 * CDK + 32 * dq;
    const char* qsb = (const char*)F.out + OQ_QSEG + (crowb * D + h * CDK) * 2;
    const char* olb = (const char*)F.out + OQ_OLOC + (crowb * D + h * CDV) * 2;
    const char* gtb = (const char*)PROJ + (rowb * DINC + C1_G + h * CDV) * 2;
    const unsigned aoff = (unsigned)(((32 * ti2 + l31) * D + 8 * hi) * 2), eoff = (unsigned)((et * D + 16 * eseg) * 2), goff = (unsigned)((et * DINC + 16 * eseg) * 2);
    float gn[16];
#pragma unroll
    for (int j = 0; j < 16; ++j) gn[j] = gnorm[16 * eseg + j];
    bf16x8 af[8]; v4u ol0, ol1, gate0, gate1;
#pragma unroll
    for (int ks = 0; ks < 8; ++ks) af[ks] = *(const bf16x8*)(qsb + ks * 32 + aoff);
    ol0 = *(const v4u*)(olb + eoff); ol1 = *(const v4u*)(olb + 16 + eoff); gate0 = *(const v4u*)(gtb + goff); gate1 = *(const v4u*)(gtb + 16 + goff);
#pragma unroll 1
    for (int c = 0; c < SEGL / GCH; ++c) {
        { const float* ea = eacc + c * CDK;
#pragma unroll
          for (int g = 0; g < 4; ++g) {
              float s8[8];
#pragma unroll
              for (int i = 0; i < 8; ++i) s8[i] = S[8 * g + i] * ea[8 * g + i];
              *(LAS v4u*)(L + GL_ST + dvt * 272 + (32 * dq + 8 * g) * 2) = (v4u){pk2(s8[0], s8[1]), pk2(s8[2], s8[3]), pk2(s8[4], s8[5]), pk2(s8[6], s8[7])};
          } }
        const int cn = (c + 1 < SEGL / GCH) ? c + 1 : c;
        bf16x8 afn[8];
#pragma unroll
        for (int ks = 0; ks < 8; ++ks) afn[ks] = *(const bf16x8*)(qsb + (long)cn * GCH * D * 2 + ks * 32 + aoff);
        const v4u ol0n = *(const v4u*)(olb + (long)cn * GCH * D * 2 + eoff), ol1n = *(const v4u*)(olb + (long)cn * GCH * D * 2 + 16 + eoff);
        const v4u gate0n = *(const v4u*)(gtb + (long)cn * GCH * DINC * 2 + goff), gate1n = *(const v4u*)(gtb + (long)cn * GCH * DINC * 2 + 16 + goff);
        __syncthreads();
        f32x16 o = {0.f, 0.f, 0.f, 0.f, 0.f, 0.f, 0.f, 0.f, 0.f, 0.f, 0.f, 0.f, 0.f, 0.f, 0.f, 0.f};
#pragma unroll
        for (int ks = 0; ks < 8; ++ks) {
            const bf16x8 sf = *(const LAS bf16x8*)(L + GL_ST + (32 * vi + l31) * 272 + (16 * ks + 8 * hi) * 2);
            o = __builtin_amdgcn_mfma_f32_32x32x16_bf16(af[ks], sf, o, 0, 0, 0);
        }
#pragma unroll
        for (int r = 0; r < 16; ++r) {
            const int crow = (r & 3) + 8 * (r >> 2) + 4 * hi;
            ((LAS float*)(L + GL_OS))[(32 * ti2 + crow) * 132 + 32 * vi + l31] = o[r];
        }
        __syncthreads();
        { const LAS f32x4* orow = (const LAS f32x4*)(L + GL_OS + (et * 132 + 16 * eseg) * 4);
          const unsigned olw[8] = {ol0.x, ol0.y, ol0.z, ol0.w, ol1.x, ol1.y, ol1.z, ol1.w};
          f32x4 ov[4];
#pragma unroll
          for (int j = 0; j < 4; ++j) { ov[j] = orow[j]; ov[j].x += bflo(olw[2 * j]); ov[j].y += bfhi(olw[2 * j]); ov[j].z += bflo(olw[2 * j + 1]); ov[j].w += bfhi(olw[2 * j + 1]); }
          gla_finish_row(ov, gate0, gate1, gn, (char*)OUT + ((rowb + (long)c * GCH) * D + h * CDV) * 2 + eoff, lane);
        }
#pragma unroll
        for (int ks = 0; ks < 8; ++ks) af[ks] = afn[ks];
        ol0 = ol0n; ol1 = ol1n; gate0 = gate0n; gate1 = gate1n;
    }
    __syncthreads();
}

constexpr int GS_Q = 0, GS_F = 2048, GS_K = 4096, GS_V = 6144, GS_OP = 8192, GS_O = GS_OP + 4 * 16 * 128 * 4, GS_G = GS_O + 2048;
constexpr int CW_DQ = 8192;
__device__ __forceinline__ int dequeue_item(const Ctx& F, gu32* ctr) {
    volatile LAS unsigned* slot = (volatile LAS unsigned*)(F.lds + MISC_OFF + 64);
    if (F.tid == 0) slot[0] = __hip_atomic_fetch_add(ctr, 1u, __ATOMIC_RELAXED, __HIP_MEMORY_SCOPE_AGENT);
    __syncthreads();
    const int v = (int)slot[0];
    __syncthreads();
    return __builtin_amdgcn_readfirstlane(v);
}
__device__ __forceinline__ void gla_sample_loop(const Ctx& F, const bf16* PROJ, bf16* OUT) {
    const int tid = F.tid;
    constexpr int NIT = NB * CH;
    gu32* ctr = (gu32*)(F.ws + WS_CTL) + CW_DQ;
    LAS float* Lq = (LAS float*)(F.lds + GS_Q); LAS float* Lf = (LAS float*)(F.lds + GS_F); LAS float* Lk = (LAS float*)(F.lds + GS_K); LAS float* Lv = (LAS float*)(F.lds + GS_V);
    LAS float* Lop = (LAS float*)(F.lds + GS_OP); LAS float* Lo = (LAS float*)(F.lds + GS_O); LAS float* Lg = (LAS float*)(F.lds + GS_G);
    const int dv4 = tid & 31, dkg = tid >> 5;
    const int svoff = (8 * dkg * CDV + 4 * dv4) * 4;
    int item = dequeue_item(F, ctr);
    if (item >= NIT) return;
    f32x4 S[8];
    { const __amdgpu_buffer_rsrc_t rs = __builtin_amdgcn_make_buffer_rsrc((void*)(F.in[5] + (size_t)item * CDK * CDV), 0, CDK * CDV * 4, 0x00020000);
#pragma unroll
      for (int i = 0; i < 8; ++i) S[i] = __builtin_bit_cast(f32x4, __builtin_amdgcn_raw_buffer_load_b128(rs, svoff, i * CDV * 4, 0)); }
    for (;;) {
        const int nxt = dequeue_item(F, ctr);
        const int nload = nxt < NIT ? nxt : NIT - 1;
        f32x4 Sn[8];
        { const __amdgpu_buffer_rsrc_t rs = __builtin_amdgcn_make_buffer_rsrc((void*)(F.in[5] + (size_t)nload * CDK * CDV), 0, CDK * CDV * 4, 0x00020000);
#pragma unroll
          for (int i = 0; i < 8; ++i) Sn[i] = __builtin_bit_cast(f32x4, __builtin_amdgcn_raw_buffer_load_b128(rs, svoff, i * CDV * 4, 0)); }
        const int s = item >> 3, h = item & 7;
        const size_t rs_ = (size_t)MP + (size_t)s * NS;
        { const int t = tid >> 7, d = tid & 127; const bf16* pr = PROJ + (rs_ + t) * DINC + h * CDK + d;
          const float lf = bf2f(pr[C1_F]), f = ex2(lf);
          Lq[tid] = bf2f(pr[C1_Q]); Lf[tid] = f; Lk[tid] = 1.0f - f; Lv[tid] = bf2f(pr[C1_I]); Lg[tid] = bf2f(pr[C1_G]); }
        __syncthreads();
#pragma unroll
        for (int t = 0; t < NS; ++t) {
            const f32x4 v4 = *(const LAS f32x4*)(Lv + t * 128 + 4 * dv4);
            f32x4 op = {0.f, 0.f, 0.f, 0.f};
#pragma unroll
            for (int g = 0; g < 2; ++g) {
                const f32x4 f4 = *(const LAS f32x4*)(Lf + t * 128 + 8 * dkg + 4 * g), k4 = *(const LAS f32x4*)(Lk + t * 128 + 8 * dkg + 4 * g), q4 = *(const LAS f32x4*)(Lq + t * 128 + 8 * dkg + 4 * g);
#pragma unroll
                for (int i = 0; i < 4; ++i) { S[4 * g + i] = S[4 * g + i] * f4[i] + v4 * k4[i]; op = op + S[4 * g + i] * q4[i]; }
            }
            *(LAS f32x4*)(Lop + (t * 16 + dkg) * 128 + 4 * dv4) = op;
        }
        { const __amdgpu_buffer_rsrc_t ro = __builtin_amdgcn_make_buffer_rsrc((void*)(F.out + O_HS + (size_t)item * CDK * CDV), 0, CDK * CDV * 4, 0x00020000);
#pragma unroll
          for (int i = 0; i < 8; ++i) __builtin_amdgcn_raw_buffer_store_b128(__builtin_bit_cast(__attribute__((__vector_size__(4 * sizeof(unsigned)))) unsigned, S[i]), ro, svoff, i * CDV * 4, 0); }
        __syncthreads();
        { const int t = tid >> 7, d = tid & 127;
          float o = 0.f;
#pragma unroll
          for (int g = 0; g < 16; ++g) o += Lop[(t * 16 + g) * 128 + d];
          const float ss = wave_sum(o * o, F.lane);
          Lo[tid] = o; ((LAS float*)(F.lds + GS_G + 2048))[tid >> 6] = ss; }
        __syncthreads();
        { const int t = tid >> 7, d = tid & 127;
          const LAS float* pss = (const LAS float*)(F.lds + GS_G + 2048);
          const float ss = pss[2 * t] + pss[2 * t + 1];
          const float rn = __builtin_amdgcn_rsqf(ss * (1.f / CDV) + EPS);
          const float g = Lg[tid];
          const float val = Lo[tid] * rn * F.in[17][d] * (g * __builtin_amdgcn_rcpf(1.0f + fexp(-g)));
          OUT[(rs_ + t) * D + h * CDV + d] = (bf16)f2bf(val); }
        __syncthreads();
        if (nxt >= NIT) break;
        item = nxt;
#pragma unroll
        for (int i = 0; i < 8; ++i) S[i] = Sn[i];
    }
}

__device__ __forceinline__ void phase_gla(const Ctx& F) {
    const bf16* PROJ = (const bf16*)(F.ws + WS_BR); bf16* OUT = (bf16*)(F.ws + WS_ACT1);
    for (int it = F.vcu; it < NGI; it += F.G) gla_prompt_item(F, PROJ, OUT, it);
}
__device__ __forceinline__ void phase_gla_fix(const Ctx& F) {
    const bf16* PROJ = (const bf16*)(F.ws + WS_BR); bf16* OUT = (bf16*)(F.ws + WS_ACT1);
    for (int it = F.vcu; it < BATCH * CH * (NSEG - 1); it += F.G) gla_fix_item(F, PROJ, OUT, it);
    const Ctx F2 = reopaque(F);
    gla_sample_loop(F2, PROJ, OUT);
}

constexpr int SG_STRIDE = 144, SG_A = 0, SG_B = 128 * SG_STRIDE, SG_STAGE = (128 + 64) * SG_STRIDE;
__device__ __forceinline__ void small_gemm(const Ctx& F, const bf16* A, int lda, const bf16* Bt, int N, int K, bf16* O, int ldc, const float* lb, int lf_c0, int lf_c1, const float* rs, int widx, int wn) {
    if (widx < 0 || widx >= wn) return;
    const int tid = F.tid, lane = F.lane, wave = F.wave, l15 = lane & 15, l4 = lane >> 4;
    const int wm = wave >> 1, wn2 = wave & 1;
    const int nun = (MS / 128) * (N / 64), nk = K / 64;
    LAS unsigned char* L = F.lds;
    const int ar = tid >> 3, akc = tid & 7;
    const unsigned aoffg = (unsigned)((ar * lda + akc * 8) * 2), boffg = (unsigned)((ar * K + akc * 8) * 2);
    const int aoffl = ar * SG_STRIDE + akc * 16;
#pragma unroll 1
    for (int u = widx; u < nun; u += wn) {
        const int rg = u & 3, cg = u >> 2;
        const int row0 = MP + rg * 128, col0 = cg * 64;
        const char* ab = (const char*)A + (long)row0 * lda * 2;
        const char* ab2 = ab + (long)64 * lda * 2;
        const char* bb = (const char*)Bt + (long)col0 * K * 2;
        f32x4 acc[2][2];
#pragma unroll
        for (int i = 0; i < 2; ++i)
#pragma unroll
            for (int j = 0; j < 2; ++j) acc[i][j] = (f32x4){0.f, 0.f, 0.f, 0.f};
        v4u ra0[4], ra1[4], rb[4];
#pragma unroll
        for (int p = 0; p < 4; ++p) { ra0[p] = *(const v4u*)(ab + p * 128 + aoffg); ra1[p] = *(const v4u*)(ab2 + p * 128 + aoffg); rb[p] = *(const v4u*)(bb + p * 128 + boffg); }
        __syncthreads();
#pragma unroll 1
        for (int s4 = 0; s4 < nk; s4 += 4) {
#pragma unroll
            for (int p = 0; p < 4; ++p) {
                const int s = s4 + p;
                LAS unsigned char* cur = L + (p & 1) * SG_STAGE;
                *(LAS v4u*)(cur + SG_A + aoffl) = ra0[p]; *(LAS v4u*)(cur + SG_A + 64 * SG_STRIDE + aoffl) = ra1[p]; *(LAS v4u*)(cur + SG_B + aoffl) = rb[p];
                __syncthreads();
                { const int sn = (s + 4 < nk) ? s + 4 : nk - 1;
                  ra0[p] = *(const v4u*)(ab + sn * 128 + aoffg); ra1[p] = *(const v4u*)(ab2 + sn * 128 + aoffg); rb[p] = *(const v4u*)(bb + sn * 128 + boffg); }
#pragma unroll
                for (int ks = 0; ks < 2; ++ks) {
                    bf16x8 af[2], bfr[2];
#pragma unroll
                    for (int i = 0; i < 2; ++i) af[i] = *(const LAS bf16x8*)(cur + SG_A + (wm * 32 + i * 16 + l15) * SG_STRIDE + (32 * ks + 8 * l4) * 2);
#pragma unroll
                    for (int j = 0; j < 2; ++j) bfr[j] = *(const LAS bf16x8*)(cur + SG_B + (wn2 * 32 + j * 16 + l15) * SG_STRIDE + (32 * ks + 8 * l4) * 2);
#pragma unroll
                    for (int i = 0; i < 2; ++i)
#pragma unroll
                        for (int j = 0; j < 2; ++j) acc[i][j] = __builtin_amdgcn_mfma_f32_16x16x32_bf16(af[i], bfr[j], acc[i][j], 0, 0, 0);
                }
            }
        }
#pragma unroll
        for (int j = 0; j < 2; ++j) {
            const int col = col0 + wn2 * 32 + j * 16 + l15;
            const bool tf = (col >= lf_c0) && (col < lf_c1);
            const float lbv = tf ? lb[col - lf_c0] : 0.f;
#pragma unroll
            for (int i = 0; i < 2; ++i) {
                char* ob = (char*)O + ((long)(row0 + wm * 32 + i * 16) * ldc + col0 + wn2 * 32 + j * 16) * 2;
                const unsigned ooff = (unsigned)((4 * l4 * ldc + l15) * 2);
#pragma unroll
                for (int r = 0; r < 4; ++r) {
                    float v = acc[i][j][r];
                    if (rs) v *= rs[row0 + wm * 32 + i * 16 + 4 * l4 + r];
                    if (tf) v = __builtin_amdgcn_logf(lbv + (1.0f - lbv) * __builtin_amdgcn_rcpf(1.0f + __expf(-v)));
                    *(bf16*)(ob + (long)r * ldc * 2 + ooff) = (bf16)f2bf(v);
                }
            }
        }
    }
}

constexpr int SF_A = 0, SF_BA = 128 * SG_STRIDE, SF_BB = (128 + 64) * SG_STRIDE, SF_STAGE = (128 + 128) * SG_STRIDE;
__device__ __forceinline__ void small_gemm_ffn(const Ctx& F, const bf16* A, int lda, const bf16* Bt, int K, bf16* G, const float* cw, const float* st_in, float* st_out, const float* rs, int widx, int wn) {
    if (widx < 0 || widx >= wn) return;
    const int tid = F.tid, lane = F.lane, wave = F.wave, l15 = lane & 15, l4 = lane >> 4;
    const int wm = wave >> 1, wn2 = wave & 1;
    const int nun = (MS / 128) * (DFF / 64), nk = K / 64;
    LAS unsigned char* L = F.lds;
    const int ar = tid >> 3, akc = tid & 7;
    const unsigned aoffg = (unsigned)((ar * lda + akc * 8) * 2), boffg = (unsigned)((ar * K + akc * 8) * 2);
    const int aoffl = ar * SG_STRIDE + akc * 16;
#pragma unroll 1
    for (int u = widx; u < nun; u += wn) {
        const int rg = u & 3, cg = u >> 2;
        const int row0 = MP + rg * 128, col0 = cg * 64;
        const char* ab = (const char*)A + (long)row0 * lda * 2;
        const char* ab2 = ab + (long)64 * lda * 2;
        const char* bba = (const char*)Bt + (long)(256 * (cg >> 1) + 64 * (cg & 1)) * K * 2;
        const char* bbb = bba + (long)128 * K * 2;
        f32x4 acca[2][2], accb[2][2];
#pragma unroll
        for (int i = 0; i < 2; ++i)
#pragma unroll
            for (int j = 0; j < 2; ++j) { acca[i][j] = (f32x4){0.f, 0.f, 0.f, 0.f}; accb[i][j] = (f32x4){0.f, 0.f, 0.f, 0.f}; }
        v4u ra0[4], ra1[4], rba[4], rbb[4];
#pragma unroll
        for (int p = 0; p < 4; ++p) { ra0[p] = *(const v4u*)(ab + p * 128 + aoffg); ra1[p] = *(const v4u*)(ab2 + p * 128 + aoffg); rba[p] = *(const v4u*)(bba + p * 128 + boffg); rbb[p] = *(const v4u*)(bbb + p * 128 + boffg); }
        __syncthreads();
#pragma unroll 1
        for (int s4 = 0; s4 < nk; s4 += 4) {
#pragma unroll
            for (int p = 0; p < 4; ++p) {
                const int s = s4 + p;
                LAS unsigned char* cur = L + (p & 1) * SF_STAGE;
                *(LAS v4u*)(cur + SF_A + aoffl) = ra0[p]; *(LAS v4u*)(cur + SF_A + 64 * SG_STRIDE + aoffl) = ra1[p]; *(LAS v4u*)(cur + SF_BA + aoffl) = rba[p]; *(LAS v4u*)(cur + SF_BB + aoffl) = rbb[p];
                __syncthreads();
                { const int sn = (s + 4 < nk) ? s + 4 : nk - 1;
                  ra0[p] = *(const v4u*)(ab + sn * 128 + aoffg); ra1[p] = *(const v4u*)(ab2 + sn * 128 + aoffg); rba[p] = *(const v4u*)(bba + sn * 128 + boffg); rbb[p] = *(const v4u*)(bbb + sn * 128 + boffg); }
#pragma unroll
                for (int ks = 0; ks < 2; ++ks) {
                    bf16x8 af[2], bfa[2], bfb[2];
#pragma unroll
                    for (int i = 0; i < 2; ++i) af[i] = *(const LAS bf16x8*)(cur + SF_A + (wm * 32 + i * 16 + l15) * SG_STRIDE + (32 * ks + 8 * l4) * 2);
#pragma unroll
                    for (int j = 0; j < 2; ++j) { bfa[j] = *(const LAS bf16x8*)(cur + SF_BA + (wn2 * 32 + j * 16 + l15) * SG_STRIDE + (32 * ks + 8 * l4) * 2);
                                                  bfb[j] = *(const LAS bf16x8*)(cur + SF_BB + (wn2 * 32 + j * 16 + l15) * SG_STRIDE + (32 * ks + 8 * l4) * 2); }
#pragma unroll
                    for (int i = 0; i < 2; ++i)
#pragma unroll
                        for (int j = 0; j < 2; ++j) { acca[i][j] = __builtin_amdgcn_mfma_f32_16x16x32_bf16(af[i], bfa[j], acca[i][j], 0, 0, 0); accb[i][j] = __builtin_amdgcn_mfma_f32_16x16x32_bf16(af[i], bfb[j], accb[i][j], 0, 0, 0); }
                }
            }
        }
#pragma unroll
        for (int j = 0; j < 2; ++j) {
            const int c = col0 + wn2 * 32 + j * 16 + l15;
            const float w0 = cw[c], w1 = cw[DFF + c], w2 = cw[2 * DFF + c];
#pragma unroll
            for (int i = 0; i < 2; ++i) {
                const int sq = (rg * 128 + wm * 32 + i * 16 + 4 * l4) >> 2;
                float am2 = st_in[(size_t)sq * 2 * DFF + c], am1 = st_in[(size_t)sq * 2 * DFF + DFF + c];
#pragma unroll
                for (int r = 0; r < 4; ++r) {
                    const float rsc = rs[MP + sq * 4 + r];
                    const float a = acca[i][j][r] * rsc;
                    const float y = w0 * am2 + w1 * am1 + w2 * a;
                    G[(size_t)(MP + sq * 4 + r) * DFF + c] = (bf16)f2bf(gelu_tanh(y) * (accb[i][j][r] * rsc));
                    am2 = am1; am1 = a;
                }
                st_out[(size_t)sq * 2 * DFF + c] = am2; st_out[(size_t)sq * 2 * DFF + DFF + c] = am1;
            }
        }
    }
}

struct Args { const float* in[22]; float* out; unsigned char* ws; int ph_lo, ph_hi; };
__global__ void __launch_bounds__(NWAVES * 64, 2) trunk_fwd(Args args) {
    extern __shared__ __attribute__((aligned(16))) unsigned char lds_raw[];
    LAS unsigned char* const lds0 = (LAS unsigned char*)lds_raw;
    volatile LAS unsigned* MISC = (volatile LAS unsigned*)(lds0 + MISC_OFF);
    for (int u = threadIdx.x; u < (LDS_BYTES - LDSCTL_OFF) / 4; u += NWAVES * 64) ((LAS unsigned*)(lds0 + LDSCTL_OFF))[u] = 0u;
    __syncthreads();
    gu32* ctl = (gu32*)(args.ws + WS_CTL);
    XcdBarrier bar; bar.bar = (unsigned*)(ctl + CW_BAR); bar.x = 0; bar.st = nullptr;
    const int lo = args.ph_lo, hi = args.ph_hi;
    if (hi - lo > 1) bar = xcd_barrier_post((unsigned*)(ctl + CW_BAR), MISC + 8);

#ifdef REPMASK
    bool rep_done = false;
#endif
    const int wave0 = __builtin_amdgcn_readfirstlane((int)threadIdx.x >> 6);
    for (int ph = lo; ph < hi; ++ph) {
        int bx_ = blockIdx.x; asm volatile("" : "+s"(bx_));
#define MKCTX() Ctx F; { int lane_; asm volatile("v_mbcnt_lo_u32_b32 %0, -1, 0\n\tv_mbcnt_hi_u32_b32 %0, -1, %0" : "=v"(lane_)); \
        F.lds = lds0; F.tid = wave0 * 64 + lane_; F.lane = lane_; F.wave = wave0; F.G = gridDim.x; F.vcu = (F.G % 8 == 0) ? (bx_ % 8) * (F.G / 8) + bx_ / 8 : bx_; \
        _Pragma("unroll") for (int i = 0; i < 22; ++i) F.in[i] = args.in[i]; \
        size_t z_ = 0; asm volatile("" : "+s"(z_)); F.out = args.out + z_; F.ws = args.ws + z_; }   \
        bf16* ACT1 = (bf16*)(F.ws + WS_ACT1); bf16* BR = (bf16*)(F.ws + WS_BR); bf16* MIX = (bf16*)(F.ws + WS_MIX); const float* LB = (const float*)(F.ws + WS_LB); \
        (void)ACT1; (void)BR; (void)MIX; (void)LB;
        switch (ph) {
        case 0: { MKCTX(); phase_prologue(F); } break;
        case 1: case 3: case 5: case 7: case 9: case 12: case 14: case 16: {
            MKCTX();
            const bf16* XBp = (const bf16*)(F.ws + WS_XB); const float* RS = (const float*)(F.ws + WS_RS);
            pg8::Gemm g; pg8::EpiGen E; E.lb = LB; E.lf_lo = 0; E.lf_hi = 0; E.mode = 0; E.cw = nullptr; E.halo = nullptr; E.a01 = nullptr; E.b01 = nullptr; E.stout = nullptr; E.xb = F.lds + XB_OFF; E.rs = nullptr;
            const int ffl = (ph == 5) ? 0 : 1;
            if (ph == 1)       { g = pg8::Gemm{XBp, (const bf16*)(F.ws + W_INAB), MP, DINAB, D, D};   E.O = BR;  E.ldc = DINAB; E.rs = RS; }
            else if (ph == 3)  { g = pg8::Gemm{ACT1, (const bf16*)(F.ws + W_OUTAB), MP, D, D, D};     E.O = MIX; E.ldc = D; }
            else if (ph == 5 || ph == 14) { g = pg8::Gemm{XBp, (const bf16*)(F.ws + (ph == 5 ? W_UP0 : W_UP1)), MP, DUP, D, D}; E.O = BR; E.ldc = DFF; E.mode = 1; E.rs = RS;
                                 E.cw = F.in[20] + (size_t)ffl * 3 * DFF; E.halo = (float*)(F.ws + WS_HALO); E.a01 = (float*)(F.ws + WS_A01); E.b01 = (float*)(F.ws + WS_B01); E.stout = F.out + O_FP + (size_t)ffl * BATCH * 2 * DFF; }
            else if (ph == 7)  { g = pg8::Gemm{BR, (const bf16*)(F.ws + W_DN0), MP, D, DFF, DFF};     E.O = ACT1; E.ldc = D; }
            else if (ph == 9)  { g = pg8::Gemm{XBp, (const bf16*)(F.ws + W_INC), MP, DINC, D, D};     E.O = BR;  E.ldc = DINC; E.lf_lo = 4; E.lf_hi = 8; E.rs = RS; }
            else if (ph == 12) { g = pg8::Gemm{ACT1, (const bf16*)(F.ws + W_OUTC), MP, D, D, D};      E.O = MIX; E.ldc = D; }
            else               { g = pg8::Gemm{BR, (const bf16*)(F.ws + W_DN1), MP, D, DFF, DFF};     E.O = ACT1; E.ldc = D; }
            pg8::StaticOrder S; S.init(g.M, g.N, F.G, bx_);
            pg8::gemm_phase<pg8::EpiGen, pg8::StaticOrder, true, true>(F.lds, g, S, E, F.tid);
            const Ctx F2 = reopaque(F);
            if (ph == 1) small_gemm(F2, g.A, g.lda, g.Bt, g.N, g.K, E.O, E.ldc, LB, 0, 0, E.rs, bx_ - 128, 128);
            else if (ph == 5 || ph == 14) small_gemm_ffn(F2, g.A, g.lda, g.Bt, g.K, BR, F.in[20] + (size_t)ffl * 3 * DFF, F.in[6] + (size_t)ffl * NB * 2 * DFF, F.out + O_FS + (size_t)ffl * NB * 2 * DFF, RS, F.vcu, F.G);
            else small_gemm(F2, g.A, g.lda, g.Bt, g.N, g.K, E.O, E.ldc, LB, E.lf_lo * 256, E.lf_hi * 256, E.rs, F.vcu, F.G);
        } break;
        case 2: { MKCTX(); phase_mixer_ab(F); } break;
        case 4:  { MKCTX(); phase_rowwise<0>(F, MIX, F.in[8]); } break;
        case 6:  { MKCTX(); phase_ffnfix(F, 0); } break;
        case 8:  { MKCTX(); phase_rowwise<1>(F, ACT1, F.in[10]); } break;
        case 10: { MKCTX(); phase_gla(F); } break;
        case 11: { MKCTX(); phase_gla_fix(F); } break;
        case 13: { MKCTX(); phase_rowwise<1>(F, MIX, F.in[8] + D); } break;
        case 15: { MKCTX(); phase_ffnfix(F, 1); } break;
        case 17: { MKCTX(); phase_rowwise<2>(F, ACT1, F.in[10] + D); } break;
        default: break;
        }
#ifdef REPMASK
        if (((REPMASK >> ph) & 1) && !rep_done) { rep_done = true; xcd_barrier(bar); --ph; continue; }
        rep_done = false;
#endif
        if (ph + 1 < hi) xcd_barrier(bar);
    }
}

extern "C" void kernel_launch(void* const* d_in, const int* in_sizes, int n_in, void* d_out, int out_size, void* d_ws, size_t ws_size, hipStream_t stream) {
    static int grid = 0;
    if (grid == 0) {
        if (n_in != 22 || (size_t)out_size != O_END || ws_size < 512 * MiB) { fprintf(stderr, "kernel_launch: unexpected shapes (n_in %d, out %d, ws %zu); nothing launched\n", n_in, out_size, ws_size); grid = -1; return; }
        int dev = 0, cus = 0, per_cu = 0;
        if (hipGetDevice(&dev) != hipSuccess || hipDeviceGetAttribute(&cus, hipDeviceAttributeMultiprocessorCount, dev) != hipSuccess) { grid = -1; return; }
        if (hipFuncSetAttribute((const void*)trunk_fwd, hipFuncAttributeMaxDynamicSharedMemorySize, LDS_BYTES) != hipSuccess) { fprintf(stderr, "kernel_launch: hipFuncSetAttribute failed\n"); grid = -1; return; }
        if (hipOccupancyMaxActiveBlocksPerMultiprocessor(&per_cu, (const void*)trunk_fwd, NWAVES * 64, LDS_BYTES) != hipSuccess || per_cu < 1)
            fprintf(stderr, "kernel_launch: occupancy query reports %d workgroups per CU\n", per_cu);
        (void)hipGetLastError();
        grid = cus;
    }
    if (grid < 0) return;
    if (hipMemsetAsync((char*)d_ws + WS_CTL, 0, CTL_ZERO_BYTES, stream) != hipSuccess) { fprintf(stderr, "kernel_launch: memset failed\n"); return; }
    Args a{};
    for (int i = 0; i < 22; ++i) a.in[i] = (const float*)d_in[i];
    a.out = (float*)d_out; a.ws = (unsigned char*)d_ws;
    const int per = (N_PHASES + N_LAUNCHES - 1) / N_LAUNCHES;
    for (int li = 0; li < N_LAUNCHES; ++li) {
        a.ph_lo = li * per; a.ph_hi = (li + 1) * per < N_PHASES ? (li + 1) * per : N_PHASES;
        if (a.ph_lo >= a.ph_hi) break;
        hipLaunchKernelGGL(trunk_fwd, dim3(grid), dim3(NWAVES * 64), LDS_BYTES, stream, a);
        const hipError_t le = hipPeekAtLastError();
        if (le != hipSuccess) { fprintf(stderr, "kernel_launch: launch %d failed: %s\n", li, hipGetErrorName(le)); break; }
    }
}
```

```cpp
#include <hip/hip_runtime.h>
#include <cstdio>
#include <cstdint>

#ifndef MK_N_LAUNCHES
#define MK_N_LAUNCHES 1
#endif

namespace pg8 {
#define PG8_LAS __attribute__((address_space(3)))
typedef unsigned short bf16_t;
typedef short bf16x8 __attribute__((ext_vector_type(8)));
typedef float f32x4 __attribute__((ext_vector_type(4)));
typedef unsigned u32x4 __attribute__((ext_vector_type(4)));
constexpr int BM = 256, BK = 64, HALF = 128, HTB = HALF * BK * 2, STAGE_BYTES = 8 * HTB, NXCD = 8, WGM = 4;

__host__ __device__ __forceinline__ int lds_byte(int r, int c) { const int st = (r >> 4) * 2 + (c >> 5), rr = r & 15, cc = c & 31, ob = rr * 64 + cc * 2; return st * 1024 + (ob ^ (((ob >> 9) & 1) << 5)); }
__host__ __device__ __forceinline__ void stage_rc(int b, int& R, int& C) { const int st = b / 1024, sb = b % 1024, swz = sb ^ (((sb >> 9) & 1) << 5); R = (st >> 1) * 16 + swz / 64; C = (st & 1) * 32 + (swz % 64) / 2; }
__host__ __device__ __forceinline__ int perm32(int rho) { const int n = rho >> 4, i = rho & 15; return 8 * (i >> 2) + 4 * n + (i & 3); }

struct Unit { int pm, pn; };
struct Gemm { const bf16_t* A; const bf16_t* Bt; int M, N, K, lda; };

struct StaticOrder {
    int nM, nN, nwg, G, c;
    __host__ __device__ void init(int M, int N, int G_, int c_) { nM = M / BM; nN = N / BM; nwg = nM * nN; G = G_; c = c_; }
    __host__ __device__ bool next(int i, Unit& u) const {
        const long L = (long)i * G + c; if (L >= nwg) return false;
        int wgid = (int)L; { const int q = nwg / NXCD, r = nwg % NXCD, xcd = wgid % NXCD, off = wgid / NXCD; wgid = (xcd < r ? xcd * (q + 1) : r * (q + 1) + (xcd - r) * q) + off; }
        const int nig = WGM * nN, gid = wgid / nig, fm = gid * WGM, gsz = (nM - fm) < WGM ? (nM - fm) : WGM;
        u.pm = fm + ((wgid % nig) % gsz); u.pn = (wgid % nig) / gsz; return true;
    }
    __device__ __forceinline__ void a_ready(const Unit&) const {}
    __device__ __forceinline__ void done(const Unit&) const {}
};

__device__ __forceinline__ unsigned cvt_pk_bf16(float lo, float hi) { unsigned r; asm volatile("v_cvt_pk_bf16_f32 %0, %1, %2" : "=v"(r) : "v"(lo), "v"(hi)); return r; }

__device__ __forceinline__ float dpp_ror1(float v) { return __builtin_bit_cast(float, __builtin_amdgcn_mov_dpp(__builtin_bit_cast(int, v), 0x121, 0xf, 0xf, true)); }
__device__ __forceinline__ float dpp_ror2(float v) { return __builtin_bit_cast(float, __builtin_amdgcn_mov_dpp(__builtin_bit_cast(int, v), 0x122, 0xf, 0xf, true)); }
__device__ __forceinline__ float gelu_tanh_e(float y) { const float u = __builtin_fmaf(y * y, -0.10294324f, -2.3022082f); return y * __builtin_amdgcn_rcpf(1.0f + __builtin_amdgcn_exp2f(y * u)); }
struct EpiGen {
    static constexpr bool PERM = true, AFTER_DRAIN = false;
    bf16_t* O; int ldc; const float* lb; int lf_lo, lf_hi;
    int mode; const float* cw; float* halo; float* a01; float* b01; float* stout; PG8_LAS unsigned char* xb;
    const float* rs;
    __device__ __forceinline__ void operator()(f32x4 (&acc)[2][2][4][2], const Unit& u, int wr, int wc, int fr, int fq) const {
        if (rs) {
#pragma unroll
            for (int ai = 0; ai < 2; ++ai)
#pragma unroll
                for (int m = 0; m < 4; ++m) { const float r = rs[u.pm * BM + ai * HALF + wr * 64 + m * 16 + fr];
#pragma unroll
                    for (int bj = 0; bj < 2; ++bj)
#pragma unroll
                        for (int n = 0; n < 2; ++n) acc[ai][bj][m][n] = acc[ai][bj][m][n] * r; }
        }
        if (mode == 1) {
            constexpr int FF = 2816;
            const int cbase = u.pn * 128 + wc * 32 + 8 * fq;
            f32x4 w0[2], w1[2], w2[2];
#pragma unroll
            for (int n = 0; n < 2; ++n) { w0[n] = *(const f32x4*)(cw + cbase + 4 * n); w1[n] = *(const f32x4*)(cw + FF + cbase + 4 * n); w2[n] = *(const f32x4*)(cw + 2 * FF + cbase + 4 * n); }
            if (fr >= 14) {
#pragma unroll
                for (int ai = 0; ai < 2; ++ai)
#pragma unroll
                    for (int n = 0; n < 2; ++n) *(PG8_LAS f32x4*)(xb + ((((ai * 2 + wr) * 2 + (fr - 14)) * 128) + wc * 32 + 8 * fq + 4 * n) * 4) = acc[ai][0][3][n];
                if (wr == 1) {
#pragma unroll
                    for (int n = 0; n < 2; ++n) { *(f32x4*)(halo + (size_t)(u.pm * 2 + fr - 14) * FF + cbase + 4 * n) = acc[1][0][3][n];
                        if ((u.pm & 15) == 15) *(f32x4*)(stout + (size_t)((u.pm >> 4) * 2 + fr - 14) * FF + cbase + 4 * n) = acc[1][0][3][n]; }
                }
            }
            if (wr == 0 && fr < 2 && (u.pm & 15) != 0) {
#pragma unroll
                for (int n = 0; n < 2; ++n) { *(f32x4*)(a01 + (size_t)(u.pm * 2 + fr) * FF + cbase + 4 * n) = acc[0][0][0][n]; *(f32x4*)(b01 + (size_t)(u.pm * 2 + fr) * FF + cbase + 4 * n) = acc[0][1][0][n]; }
            }
            asm volatile("s_waitcnt lgkmcnt(0)" ::: "memory"); __builtin_amdgcn_s_barrier(); asm volatile("" ::: "memory");
#pragma unroll
            for (int ai = 0; ai < 2; ++ai) {
                f32x4 bnd[2] = {(f32x4){0.f, 0.f, 0.f, 0.f}, (f32x4){0.f, 0.f, 0.f, 0.f}};
                if (!(ai == 0 && wr == 0) && fr >= 14) {
                    const int sidx = (wr == 1) ? ai * 2 : (ai - 1) * 2 + 1;
#pragma unroll
                    for (int n = 0; n < 2; ++n) bnd[n] = *(const PG8_LAS f32x4*)(xb + (((sidx * 2 + (fr - 14)) * 128) + wc * 32 + 8 * fq + 4 * n) * 4);
                }
#pragma unroll
                for (int m = 0; m < 4; ++m) {
                    float g[8];
#pragma unroll
                    for (int n = 0; n < 2; ++n)
#pragma unroll
                        for (int i = 0; i < 4; ++i) {
                            const float cur = acc[ai][0][m][n][i];
                            const float pb = (m > 0) ? acc[ai][0][m > 0 ? m - 1 : 0][n][i] : bnd[n][i];
                            const float p1 = dpp_ror1(fr == 15 ? pb : cur), p2 = dpp_ror2(fr >= 14 ? pb : cur);
                            const float y = __builtin_fmaf(p2, w0[n][i], __builtin_fmaf(p1, w1[n][i], w2[n][i] * cur));
                            g[4 * n + i] = gelu_tanh_e(y) * acc[ai][1][m][n][i];
                        }
                    u32x4 w; w.x = cvt_pk_bf16(g[0], g[1]); w.y = cvt_pk_bf16(g[2], g[3]); w.z = cvt_pk_bf16(g[4], g[5]); w.w = cvt_pk_bf16(g[6], g[7]);
                    *(u32x4*)(O + (size_t)(u.pm * BM + ai * HALF + wr * 64 + m * 16 + fr) * FF + cbase) = w;
                }
            }
            return;
        }
        const int row0 = u.pm * BM + wr * 64 + fr; const int col0 = u.pn * BM + wc * 32 + 8 * fq;
        const bool tf = (u.pn >= lf_lo) && (u.pn < lf_hi);
        f32x4 lbv[2][2];
#pragma unroll
        for (int bj = 0; bj < 2; ++bj)
#pragma unroll
            for (int n = 0; n < 2; ++n) lbv[bj][n] = tf ? *(const f32x4*)(lb + (col0 - BM * lf_lo) + bj * HALF + 4 * n) : (f32x4){0.f, 0.f, 0.f, 0.f};
#pragma unroll
        for (int ai = 0; ai < 2; ++ai)
#pragma unroll
            for (int m = 0; m < 4; ++m) { bf16_t* rowp = O + (size_t)(row0 + ai * HALF + m * 16) * ldc + col0;
#pragma unroll
                for (int bj = 0; bj < 2; ++bj) { f32x4 v0 = acc[ai][bj][m][0], v1 = acc[ai][bj][m][1];
                    if (tf) {
#pragma unroll
                        for (int j = 0; j < 4; ++j) {
                            const float s0 = __builtin_amdgcn_rcpf(1.0f + __expf(-v0[j])), s1 = __builtin_amdgcn_rcpf(1.0f + __expf(-v1[j]));
                            v0[j] = __builtin_amdgcn_logf(lbv[bj][0][j] + (1.0f - lbv[bj][0][j]) * s0); v1[j] = __builtin_amdgcn_logf(lbv[bj][1][j] + (1.0f - lbv[bj][1][j]) * s1); } }
                    u32x4 w; w.x = cvt_pk_bf16(v0[0], v0[1]); w.y = cvt_pk_bf16(v0[2], v0[3]); w.z = cvt_pk_bf16(v1[0], v1[1]); w.w = cvt_pk_bf16(v1[2], v1[3]);
                    *(u32x4*)(rowp + bj * HALF) = w; } }
    }
};

template <class Epi, class Sched, bool ALIGN_EPI = false, bool SP2 = false>
__device__ __forceinline__ void gemm_phase(PG8_LAS unsigned char* lds, const Gemm g, const Sched& S, const Epi& E, const int tid) {
    const int wid = __builtin_amdgcn_readfirstlane(tid >> 6), lane = tid & 63, wr = wid >> 2, wc = wid & 3, fr = lane & 15, fq = lane >> 4;
    const int K = g.K, nt = K / BK, lda = g.lda;
    unsigned voffA[2], voffB[2];
#pragma unroll
    for (int i = 0; i < 2; ++i) { int R, C; stage_rc(tid * 16 + i * 8192, R, C); const int Rb = Epi::PERM ? ((R & ~31) + perm32(R & 31)) : R;
        voffA[i] = (unsigned)(R * lda + C) * 2u; voffB[i] = (unsigned)(Rb * K + C) * 2u; }
    const size_t kstep = (size_t)(BK * 2);
    const size_t hstepA = (size_t)HALF * lda * 2, hstepB = (size_t)HALF * K * 2;
    const size_t tstepA = 2 * hstepA, tstepB = 2 * hstepB;
    const unsigned ldsw = (unsigned)wid * 1024u;
    const int aoff = lds_byte(wr * 64 + fr, fq * 8), boff = lds_byte(wc * 32 + fr, fq * 8);
#define PG8_SA(b, h) (((b) * 2 + (h)) * HTB)
#define PG8_SB(b, h) ((4 + (b) * 2 + (h)) * HTB)
#define PG8_STAGE(bufoff, gbase, voff) do { _Pragma("unroll") for (int _i = 0; _i < 2; ++_i) \
        __builtin_amdgcn_global_load_lds((const unsigned*)((const char*)(gbase) + (voff)[_i]), (PG8_LAS unsigned*)(lds + (bufoff) + ldsw + _i * 8192), 16, 0, 0); } while (0)
#define PG8_LDA(dst, b, h) do { _Pragma("unroll") for (int m = 0; m < 4; ++m) _Pragma("unroll") for (int k = 0; k < 2; ++k) dst[m][k] = *(const PG8_LAS bf16x8*)(lds + PG8_SA(b, h) + aoff + m * 2048 + k * 1024); } while (0)
#define PG8_LDB(dst, b, h) do { _Pragma("unroll") for (int n = 0; n < 2; ++n) _Pragma("unroll") for (int k = 0; k < 2; ++k) dst[n][k] = *(const PG8_LAS bf16x8*)(lds + PG8_SB(b, h) + boff + n * 2048 + k * 1024); } while (0)
#define PG8_MMA(ai, bj, At, Bt) do { __builtin_amdgcn_s_setprio(1); _Pragma("unroll") for (int m = 0; m < 4; ++m) _Pragma("unroll") for (int n = 0; n < 2; ++n) _Pragma("unroll") for (int k = 0; k < 2; ++k) \
        acc[ai][bj][m][n] = __builtin_amdgcn_mfma_f32_16x16x32_bf16(Bt[n][k], At[m][k], acc[ai][bj][m][n], 0, 0, 0); __builtin_amdgcn_s_setprio(0); } while (0)
#define PG8_WAIT_V(n) asm volatile("s_waitcnt vmcnt(" #n ")" ::: "memory")
#define PG8_WAIT_L(n) asm volatile("s_waitcnt lgkmcnt(" #n ")" ::: "memory")
#define PG8_BAR __builtin_amdgcn_s_barrier()
#define PG8_SCHED __builtin_amdgcn_sched_barrier(0)
    Unit cur, nxt; int ui = 0;
    if (!S.next(0, cur)) return;
    f32x4 acc[2][2][4][2];
#pragma unroll
    for (int a = 0; a < 2; ++a)
#pragma unroll
        for (int b = 0; b < 2; ++b)
#pragma unroll
            for (int m = 0; m < 4; ++m)
#pragma unroll
                for (int n = 0; n < 2; ++n) acc[a][b][m][n] = (f32x4){0.f, 0.f, 0.f, 0.f};
    bf16x8 At[4][2], B0[2][2], B1[2][2];
    const char* cA = (const char*)g.A + (size_t)cur.pm * tstepA; const char* cB = (const char*)g.Bt + (size_t)cur.pn * tstepB;
    S.a_ready(cur);
    if constexpr (SP2) {
        PG8_STAGE(PG8_SB(0, 0), cB, voffB); PG8_STAGE(PG8_SB(0, 1), cB + hstepB, voffB); PG8_STAGE(PG8_SA(0, 0), cA, voffA); PG8_STAGE(PG8_SA(0, 1), cA + hstepA, voffA);
        if (wr == 1) PG8_BAR;
        PG8_WAIT_V(2); PG8_BAR;
        PG8_STAGE(PG8_SB(1, 0), cB + kstep, voffB); PG8_STAGE(PG8_SA(1, 0), cA + kstep, voffA); PG8_STAGE(PG8_SB(1, 1), cB + hstepB + kstep, voffB);
        PG8_WAIT_V(6); PG8_BAR;
    } else {
        PG8_STAGE(PG8_SB(0, 0), cB, voffB); PG8_STAGE(PG8_SA(0, 0), cA, voffA); PG8_STAGE(PG8_SB(0, 1), cB + hstepB, voffB); PG8_STAGE(PG8_SA(0, 1), cA + hstepA, voffA);
        if (wr == 1) PG8_BAR;
        PG8_WAIT_V(4); PG8_BAR;
        PG8_STAGE(PG8_SB(1, 0), cB + kstep, voffB); PG8_STAGE(PG8_SA(1, 0), cA + kstep, voffA); PG8_STAGE(PG8_SB(1, 1), cB + hstepB + kstep, voffB);
        PG8_WAIT_V(6); PG8_BAR;
    }
    for (;;) {
        const bool has_next = S.next(ui + 1, nxt);
        const char* nA = has_next ? (const char*)g.A + (size_t)nxt.pm * tstepA : cA; const char* nB = has_next ? (const char*)g.Bt + (size_t)nxt.pn * tstepB : cB;
        for (int t = 0; t < nt; t += 2) {
            const bool last = (t == nt - 2);
            const char* a1 = cA + (size_t)(t + 1) * kstep;
            const char* a2 = last ? nA : cA + (size_t)(t + 2) * kstep; const char* b2 = last ? nB : cB + (size_t)(t + 2) * kstep;
            const char* a3 = a2 + kstep; const char* b3 = b2 + kstep;
            if (last && has_next) S.a_ready(nxt);
            if constexpr (SP2) {
            PG8_LDB(B0, 0, 0); PG8_LDB(B1, 0, 1); PG8_SCHED; PG8_LDA(At, 0, 0); PG8_STAGE(PG8_SA(1, 1), a1 + hstepA, voffA);
            PG8_WAIT_V(8); PG8_WAIT_L(0); PG8_BAR; PG8_MMA(0, 0, At, B0); PG8_MMA(0, 1, At, B1); PG8_BAR; PG8_SCHED;
            PG8_LDA(At, 0, 1); PG8_STAGE(PG8_SB(0, 0), b2, voffB); PG8_STAGE(PG8_SB(0, 1), b2 + hstepB, voffB); PG8_STAGE(PG8_SA(0, 0), a2, voffA);
            PG8_WAIT_V(8); PG8_WAIT_L(0); PG8_BAR; PG8_MMA(1, 0, At, B0); PG8_MMA(1, 1, At, B1); PG8_BAR; PG8_SCHED;
            PG8_LDB(B0, 1, 0); PG8_LDB(B1, 1, 1); PG8_SCHED; PG8_LDA(At, 1, 0); PG8_STAGE(PG8_SA(0, 1), a2 + hstepA, voffA);
            PG8_WAIT_V(8); PG8_WAIT_L(0); PG8_BAR; PG8_MMA(0, 0, At, B0); PG8_MMA(0, 1, At, B1); PG8_BAR; PG8_SCHED;
            PG8_LDA(At, 1, 1); PG8_STAGE(PG8_SB(1, 0), b3, voffB); PG8_STAGE(PG8_SB(1, 1), b3 + hstepB, voffB); PG8_STAGE(PG8_SA(1, 0), a3, voffA);
            PG8_WAIT_V(8); PG8_WAIT_L(0); PG8_BAR; PG8_MMA(1, 0, At, B0); PG8_MMA(1, 1, At, B1); PG8_BAR; PG8_SCHED;
            } else {
            PG8_LDB(B0, 0, 0); PG8_SCHED; PG8_LDA(At, 0, 0); PG8_STAGE(PG8_SA(1, 1), a1 + hstepA, voffA);
            PG8_WAIT_L(8); PG8_BAR; PG8_WAIT_L(0); PG8_MMA(0, 0, At, B0); PG8_BAR; PG8_SCHED;
            PG8_LDB(B1, 0, 1); PG8_STAGE(PG8_SB(0, 0), b2, voffB);
            PG8_BAR; PG8_WAIT_L(0); PG8_MMA(0, 1, At, B1); PG8_BAR;
            PG8_LDA(At, 0, 1); PG8_STAGE(PG8_SA(0, 0), a2, voffA);
            PG8_BAR; PG8_WAIT_L(0); PG8_MMA(1, 0, At, B0); PG8_BAR; PG8_SCHED;
            PG8_STAGE(PG8_SB(0, 1), b2 + hstepB, voffB);
            PG8_WAIT_V(6); PG8_BAR; PG8_MMA(1, 1, At, B1); PG8_BAR;
            PG8_LDB(B0, 1, 0); PG8_SCHED; PG8_LDA(At, 1, 0); PG8_STAGE(PG8_SA(0, 1), a2 + hstepA, voffA);
            PG8_WAIT_L(8); PG8_BAR; PG8_WAIT_L(0); PG8_MMA(0, 0, At, B0); PG8_BAR; PG8_SCHED;
            PG8_LDB(B1, 1, 1); PG8_STAGE(PG8_SB(1, 0), b3, voffB);
            PG8_BAR; PG8_WAIT_L(0); PG8_MMA(0, 1, At, B1); PG8_BAR;
            PG8_LDA(At, 1, 1); PG8_STAGE(PG8_SA(1, 0), a3, voffA);
            PG8_BAR; PG8_WAIT_L(0); PG8_MMA(1, 0, At, B0); PG8_BAR; PG8_SCHED;
            PG8_STAGE(PG8_SB(1, 1), b3 + hstepB, voffB);
            PG8_WAIT_V(6); PG8_BAR; PG8_MMA(1, 1, At, B1); PG8_BAR;
            }
        }
        if constexpr (ALIGN_EPI) { if (wr == 0) PG8_BAR; }
        if constexpr (!Epi::AFTER_DRAIN) { E(acc, cur, wr, wc, fr, fq); S.done(cur); }
        if (!has_next) break;
#pragma unroll
        for (int a = 0; a < 2; ++a)
#pragma unroll
            for (int b = 0; b < 2; ++b)
#pragma unroll
                for (int m = 0; m < 4; ++m)
#pragma unroll
                    for (int n = 0; n < 2; ++n) acc[a][b][m][n] = (f32x4){0.f, 0.f, 0.f, 0.f};
        cur = nxt; cA = nA; cB = nB; ++ui;
        if constexpr (ALIGN_EPI) { if (wr == 1) PG8_BAR; }
    }
    PG8_WAIT_V(0);
    if constexpr (!ALIGN_EPI) { if (wr == 0) PG8_BAR; }
    PG8_BAR;
#undef PG8_SA
#undef PG8_SB
#undef PG8_STAGE
#undef PG8_LDA
#undef PG8_LDB
#undef PG8_MMA
#undef PG8_WAIT_V
#undef PG8_WAIT_L
#undef PG8_BAR
#undef PG8_SCHED
}
}

constexpr int NWAVES = 8;
constexpr int N_LAUNCHES = MK_N_LAUNCHES;
constexpr int N_PHASES = 18;
constexpr int D = 1024, BATCH = 8, SEQ = 4096, NB = 128, NS = 4;
constexpr int MP = BATCH * SEQ, MS = NB * NS, MT = MP + MS;
constexpr int AW = 512, NKV = 2, HD = 64, WIN = 128;
constexpr int DINAB = 2304, DINC = 4096, DFF = 2816, DUP = 5632;
constexpr int CH = 8, CDK = 128, CDV = 128, GCH = 64;
constexpr float EPS = 1e-6f;
constexpr float LOG2E = 1.4426950408889634f;
constexpr int C_H = 0, C_GB = 512, C_GC = 1024, C_Q = 1536, C_K = 2048, C_V = 2176;
constexpr int C1_Q = 0, C1_F = 1024, C1_I = 2048, C1_G = 3072;

constexpr size_t O_Y = 0;
constexpr size_t O_CAP = (size_t)MT * D;
constexpr size_t O_CAS = O_CAP + (size_t)BATCH * 2 * AW;
constexpr size_t O_KP = O_CAS + (size_t)NB * 2 * AW;
constexpr size_t O_KS = O_KP + (size_t)BATCH * WIN * NKV * HD;
constexpr size_t O_VP = O_KS + (size_t)NB * WIN * NKV * HD;
constexpr size_t O_VS = O_VP + (size_t)BATCH * WIN * NKV * HD;
constexpr size_t O_HP = O_VS + (size_t)NB * WIN * NKV * HD;
constexpr size_t O_HS = O_HP + (size_t)BATCH * CH * CDK * CDV;
constexpr size_t O_FP = O_HS + (size_t)NB * CH * CDK * CDV;
constexpr size_t O_FS = O_FP + (size_t)2 * BATCH * 2 * DFF;
constexpr size_t O_END = O_FS + (size_t)2 * NB * 2 * DFF;
static_assert(O_END == 58032128, "output size");

constexpr size_t MiB = 1u << 20;
constexpr size_t WS_CTL = 0, CTL_ZERO_BYTES = 1 * MiB;
constexpr size_t WS_LB = 1 * MiB;
constexpr size_t WS_RS = 1 * MiB + 64 * 1024;
constexpr size_t W_INAB = 2 * MiB;
constexpr size_t W_OUTAB = W_INAB + (size_t)DINAB * D * 2;
constexpr size_t W_INC = W_OUTAB + (size_t)D * D * 2;
constexpr size_t W_OUTC = W_INC + (size_t)DINC * D * 2;
constexpr size_t W_UP0 = W_OUTC + (size_t)D * D * 2;
constexpr size_t W_UP1 = W_UP0 + (size_t)DUP * D * 2;
constexpr size_t W_DN0 = W_UP1 + (size_t)DUP * D * 2;
constexpr size_t W_DN1 = W_DN0 + (size_t)D * DFF * 2;
constexpr size_t W_END = W_DN1 + (size_t)D * DFF * 2;
constexpr size_t WS_ACT1 = 54 * MiB;
constexpr size_t WS_XB = 119 * MiB;
constexpr size_t WS_BR = 184 * MiB;
constexpr size_t WS_MIX = WS_BR;
constexpr size_t WS_END = WS_BR + (size_t)MT * DINC * 2;
static_assert(W_END <= WS_ACT1 && WS_ACT1 + (size_t)MT * D * 2 <= WS_XB && WS_XB + (size_t)MT * D * 2 <= WS_BR && WS_END <= 512 * MiB && WS_RS + (size_t)MT * 4 <= 2 * MiB, "ws map");
constexpr int NSEG = 4, SEGL = SEQ / NSEG, NGI = BATCH * CH * NSEG;
constexpr size_t OQ_QSEG = 0;
constexpr size_t OQ_OLOC = OQ_QSEG + 48 * MiB;
constexpr size_t OQ_DS = OQ_OLOC + 48 * MiB;
constexpr size_t OQ_DD = OQ_DS + (size_t)NGI * CDK * CDV * 4;
constexpr size_t OQ_EACC = OQ_DD + 256 * 1024;
static_assert(OQ_EACC + (size_t)NGI * 16 * CDK * 4 <= (size_t)MT * D * 4, "GLA scratch fits the y region of d_out");
constexpr size_t WS_HALO = WS_BR + 182 * MiB, WS_A01 = WS_HALO + 3 * MiB, WS_B01 = WS_A01 + 3 * MiB;
static_assert((size_t)128 * 2 * DFF * 4 <= 3 * MiB && WS_BR + (size_t)MT * DFF * 2 <= WS_HALO && WS_B01 + 3 * MiB <= WS_END, "ws map 4");
constexpr int XB_OFF = 131072;
constexpr int CW_BAR = 4096;

constexpr int LDS_BYTES = 147456;
constexpr int LDSCTL_OFF = 143360, MISC_OFF = LDSCTL_OFF + 320;

#define GAS __attribute__((address_space(1)))
#define LAS __attribute__((address_space(3)))
typedef unsigned short bf16;
typedef unsigned v4u __attribute__((ext_vector_type(4)));
typedef unsigned v2u __attribute__((ext_vector_type(2)));
typedef float f32x4 __attribute__((ext_vector_type(4)));
typedef float f32x16 __attribute__((ext_vector_type(16)));
typedef short bf16x8 __attribute__((ext_vector_type(8)));
typedef GAS unsigned gu32;
#define RLX_AGENT __ATOMIC_RELAXED, __HIP_MEMORY_SCOPE_AGENT
#define LDS_WAIT() asm volatile("s_waitcnt lgkmcnt(0)" ::: "memory")
typedef float f32x2_t __attribute__((ext_vector_type(2))); typedef __bf16 bf16x2_t __attribute__((ext_vector_type(2)));
__device__ __forceinline__ unsigned pk2(float lo, float hi) { f32x2_t v = {lo, hi}; bf16x2_t b = __builtin_convertvector(v, bf16x2_t); return __builtin_bit_cast(unsigned, b); }
__device__ __forceinline__ unsigned f2bf(float f) { __bf16 b = (__bf16)f; return (unsigned)__builtin_bit_cast(unsigned short, b); }
__device__ __forceinline__ float bflo(unsigned w) { return __builtin_bit_cast(float, w << 16); }
__device__ __forceinline__ float bfhi(unsigned w) { return __builtin_bit_cast(float, w & 0xffff0000u); }
__device__ __forceinline__ float bf2f(unsigned short b) { return __builtin_bit_cast(float, ((unsigned)b) << 16); }
__device__ __forceinline__ float ex2(float x) { return __builtin_amdgcn_exp2f(x); }
__device__ __forceinline__ float fexp(float x) { return __builtin_amdgcn_exp2f(x * LOG2E); }

#define XB_TMO      128
#define XB_XCNT(j)  (256  + 64 * (j))
#define XB_XSUB(j)  (1280 + 64 * (j))
#define XB_XGEN(j)  (2304 + 64 * (j))
#define XB_TOP      3328
#define XB_TOPGEN   3392
#define XCD_BAR_WORDS 3456
#define XB_SPIN_CAP (1u << 18)
__device__ __forceinline__ unsigned xb_ld(unsigned* p)              { return __hip_atomic_load(p, __ATOMIC_RELAXED, __HIP_MEMORY_SCOPE_AGENT); }
__device__ __forceinline__ unsigned xb_add(unsigned* p, unsigned v) { return __hip_atomic_fetch_add(p, v, __ATOMIC_RELAXED, __HIP_MEMORY_SCOPE_AGENT); }
__device__ __forceinline__ unsigned xb_xcc_id() { return (unsigned)__builtin_amdgcn_s_getreg((3 << 11) | 20) & 0xFu; }
#define XB_SPIN(cond, bar) do { unsigned _sp = 0; while (cond) { __builtin_amdgcn_s_sleep(1); \
    if ((++_sp & 255u) == 0u) { if (xb_ld(&(bar)[XB_TMO])) break; if (_sp > XB_SPIN_CAP) { atomicAdd(&(bar)[XB_TMO], 1u); break; } } } } while (0)
struct XcdBarrier { unsigned* bar; unsigned x; volatile LAS unsigned* st; };
__device__ __forceinline__ XcdBarrier xcd_barrier_post(unsigned* bar, volatile LAS unsigned* st) {
    XcdBarrier b; b.bar = bar; b.x = xb_xcc_id(); b.st = st;
    if (threadIdx.x == 0) (void)xb_add(&bar[XB_XCNT(b.x)], 1u);
    return b;
}
__device__ __forceinline__ void xcd_barrier_complete(unsigned* bar, unsigned x, unsigned& nloc, unsigned& nx) {
    const unsigned G = gridDim.x * gridDim.y * gridDim.z;
    unsigned sum, cnt, mine, sp = 0u;
    for (;;) {
        sum = 0u; cnt = 0u; mine = 0u;
#pragma unroll
        for (unsigned j = 0; j < 16; ++j) { const unsigned c = xb_ld(&bar[XB_XCNT(j)]); sum += c; cnt += (c > 0u) ? 1u : 0u; mine = (j == x) ? c : mine; }
        if (sum == G) break;
        __builtin_amdgcn_s_sleep(1);
        if ((++sp & 255u) == 0u) { if (xb_ld(&bar[XB_TMO])) break; if (sp > XB_SPIN_CAP) { atomicAdd(&bar[XB_TMO], 1u); break; } }
    }
    nloc = mine > 0u ? mine : 1u; nx = cnt > 0u ? cnt : 1u;
}
__device__ __forceinline__ void xcd_barrier(const XcdBarrier& b) {
    asm volatile("s_waitcnt vmcnt(0)" ::: "memory");
    __syncthreads();
    if (threadIdx.x == 0) {
        unsigned* bar = b.bar;
        __builtin_amdgcn_s_waitcnt(0);
        unsigned nloc = b.st[0], nx = b.st[1];
        if (nloc == 0u) { xcd_barrier_complete(bar, b.x, nloc, nx); b.st[0] = nloc; b.st[1] = nx; }
        const unsigned old = xb_add(&bar[XB_XSUB(b.x)], 1u);
        const unsigned gen = old / nloc;
        if (old + 1u == (gen + 1u) * nloc) {
            __builtin_amdgcn_fence(__ATOMIC_RELEASE, "agent");
            asm volatile("s_waitcnt vmcnt(0)" ::: "memory");
            const unsigned og = xb_add(&bar[XB_TOP], 1u);
            const unsigned tg = og / nx;
            if (og + 1u == (tg + 1u) * nx) xb_add(&bar[XB_TOPGEN], 1u);
            else XB_SPIN(xb_ld(&bar[XB_TOPGEN]) == tg, bar);
            __builtin_amdgcn_fence(__ATOMIC_ACQUIRE, "agent");
            xb_add(&bar[XB_XGEN(b.x)], 1u);
            asm volatile("s_waitcnt vmcnt(0)" ::: "memory");
        } else {
            XB_SPIN(xb_ld(&bar[XB_XGEN(b.x)]) == gen, bar);
            __builtin_amdgcn_fence(__ATOMIC_ACQUIRE, "agent");
            asm volatile("s_waitcnt vmcnt(0)" ::: "memory");
        }
    }
    __syncthreads();
}

__device__ __forceinline__ float shx(float v, int o, int lane) { return __builtin_bit_cast(float, __builtin_amdgcn_ds_bpermute((lane ^ o) << 2, __builtin_bit_cast(int, v))); }
__device__ __forceinline__ float wave_sum(float v, int lane) {
#pragma unroll
    for (int o = 1; o < 64; o <<= 1) v += shx(v, o, lane);
    return v;
}
struct Ctx {
    LAS unsigned char* lds;
    int tid, lane, wave, vcu, G;
    const float* in[22];
    float* out;
    unsigned char* ws;
};

__device__ __forceinline__ Ctx reopaque(const Ctx& F) { Ctx G = F; int l; asm volatile("v_mbcnt_lo_u32_b32 %0, -1, 0\n\tv_mbcnt_hi_u32_b32 %0, -1, %0" : "=v"(l)); G.lane = l; G.tid = F.wave * 64 + l; return G; }

struct TrItem { const float* W; bf16* WT; const float* gain; int K, N, item, perm; };
__device__ __forceinline__ TrItem tr_decode(const Ctx& F, int it) {
    constexpr int I_INAB = (D / 64) * (DINAB / 32), I_SQ = (D / 64) * (D / 32), I_INC = (D / 64) * (DINC / 32), I_UP = (D / 64) * (DUP / 32), I_DN = (DFF / 64) * (D / 32);
    TrItem t; int r = it; t.gain = nullptr; t.perm = 0; t.K = D;
    if (r < I_INAB) { t.W = F.in[11]; t.N = DINAB; t.WT = (bf16*)(F.ws + W_INAB); t.gain = F.in[7]; t.item = r; return t; } r -= I_INAB;
    if (r < I_SQ) { t.W = F.in[14]; t.N = D; t.WT = (bf16*)(F.ws + W_OUTAB); t.item = r; return t; } r -= I_SQ;
    if (r < I_INC) { t.W = F.in[15]; t.N = DINC; t.WT = (bf16*)(F.ws + W_INC); t.gain = F.in[7] + D; t.item = r; return t; } r -= I_INC;
    if (r < I_SQ) { t.W = F.in[18]; t.N = D; t.WT = (bf16*)(F.ws + W_OUTC); t.item = r; return t; } r -= I_SQ;
    if (r < I_UP) { t.W = F.in[19]; t.N = DUP; t.WT = (bf16*)(F.ws + W_UP0); t.gain = F.in[9]; t.perm = 1; t.item = r; return t; } r -= I_UP;
    if (r < I_UP) { t.W = F.in[19] + (size_t)D * DUP; t.N = DUP; t.WT = (bf16*)(F.ws + W_UP1); t.gain = F.in[9] + D; t.perm = 1; t.item = r; return t; } r -= I_UP;
    t.K = DFF; t.N = D;
    if (r < I_DN) { t.W = F.in[21]; t.WT = (bf16*)(F.ws + W_DN0); t.item = r; return t; } r -= I_DN;
    t.W = F.in[21] + (size_t)DFF * D; t.WT = (bf16*)(F.ws + W_DN1); t.item = r; return t;
}
__device__ __forceinline__ void tr_load(const TrItem& t, int lane, f32x4 (&v)[8], float (&gg)[8]) {
    const int nblk = t.N / 32, kb = t.item / nblk, nb = t.item - kb * nblk, k0 = 64 * kb, n0 = 32 * nb;
#pragma unroll
    for (int i = 0; i < 8; ++i) { const int kk = 8 * i + (lane >> 3); v[i] = *(const f32x4*)(t.W + (size_t)(k0 + kk) * t.N + n0 + 4 * (lane & 7)); gg[i] = t.gain ? t.gain[k0 + kk] : 1.0f; }
}
__device__ __forceinline__ void tr_store(const TrItem& t, int lane, const f32x4 (&v)[8], const float (&gg)[8], LAS float* scr) {
    const int nblk = t.N / 32, kb = t.item / nblk, nb = t.item - kb * nblk, k0 = 64 * kb, n0 = 32 * nb;
    const int d0 = t.perm ? ((n0 < DFF) ? (256 * (n0 >> 7) + (n0 & 127)) : (256 * ((n0 - DFF) >> 7) + 128 + ((n0 - DFF) & 127))) : n0;
#pragma unroll
    for (int i = 0; i < 8; ++i) { LAS float* dd = scr + (8 * i + (lane >> 3)) * 33 + 4 * (lane & 7); dd[0] = v[i].x * gg[i]; dd[1] = v[i].y * gg[i]; dd[2] = v[i].z * gg[i]; dd[3] = v[i].w * gg[i]; }
    LDS_WAIT(); asm volatile("" ::: "memory");
    const int c = lane & 7;
#pragma unroll
    for (int j = 0; j < 4; ++j) { const int n = (lane >> 3) + 8 * j; const LAS float* s = scr + (8 * c) * 33 + n;
        v4u o; o.x = pk2(s[0 * 33], s[1 * 33]); o.y = pk2(s[2 * 33], s[3 * 33]); o.z = pk2(s[4 * 33], s[5 * 33]); o.w = pk2(s[6 * 33], s[7 * 33]);
        *(GAS v4u*)(t.WT + (size_t)(d0 + n) * t.K + k0 + 8 * c) = o; }
    LDS_WAIT(); asm volatile("" ::: "memory");
}

__device__ __forceinline__ void phase_prologue(const Ctx& F) {
    LAS float* scr = (LAS float*)(F.lds + F.wave * 16384);
    const int gw = F.vcu * NWAVES + F.wave, NGW = F.G * NWAVES;
    constexpr int I_INAB = (D / 64) * (DINAB / 32), I_SQ = (D / 64) * (D / 32), I_INC = (D / 64) * (DINC / 32), I_UP = (D / 64) * (DUP / 32), I_DN = (DFF / 64) * (D / 32);
    constexpr int NITEMS = I_INAB + 2 * I_SQ + I_INC + 2 * I_UP + 2 * I_DN;
    if (gw < NITEMS) {
        f32x4 v[8]; float gg[8];
        TrItem cur = tr_decode(F, gw); tr_load(cur, F.lane, v, gg);
        for (int it = gw; it < NITEMS; it += NGW) {
            const int itn = (it + NGW < NITEMS) ? it + NGW : it;
            const TrItem nxt = tr_decode(F, itn);
            f32x4 vn[8]; float gn[8];
            tr_load(nxt, F.lane, vn, gn);
            tr_store(cur, F.lane, v, gg, scr);
            cur = nxt;
#pragma unroll
            for (int i = 0; i < 8; ++i) { v[i] = vn[i]; gg[i] = gn[i]; }
        }
    }
    { bf16* XB = (bf16*)(F.ws + WS_XB); float* RS = (float*)(F.ws + WS_RS); const int lane = F.lane;
      f32x4 xq[3][4];
#define P0_LOAD(slot, mm) do { const int m_ = (mm) < MT ? (mm) : MT - 1; const float* xr_ = m_ < MP ? F.in[0] + (size_t)m_ * D : F.in[1] + (size_t)(m_ - MP) * D; \
        _Pragma("unroll") for (int j = 0; j < 4; ++j) xq[slot][j] = ((const f32x4*)xr_)[64 * j + lane]; } while (0)
      P0_LOAD(0, gw); P0_LOAD(1, gw + NGW);
      for (int m = gw; m < MT; m += NGW) {
          P0_LOAD(2, m + 2 * NGW);
          float s = 0.f;
          unsigned long long* o8 = (unsigned long long*)(XB + (size_t)m * D) + lane;
#pragma unroll
          for (int j = 0; j < 4; ++j) { const f32x4 x = xq[0][j]; s += (x.x * x.x + x.y * x.y) + (x.z * x.z + x.w * x.w);
              o8[64 * j] = (unsigned long long)pk2(x.x, x.y) | ((unsigned long long)pk2(x.z, x.w) << 32); }
          const float r = __builtin_amdgcn_rsqf(wave_sum(s, lane) * (1.f / D) + EPS);
          if (lane == 0) RS[m] = r;
#pragma unroll
          for (int j = 0; j < 4; ++j) { xq[0][j] = xq[1][j]; xq[1][j] = xq[2][j]; }
      }
#undef P0_LOAD
    }
    float* LB = (float*)(F.ws + WS_LB);
    for (int i = F.vcu * 512 + F.tid; i < CH * CDK; i += F.G * 512) {
        const float l0 = F.in[16][i], l1 = F.in[16][CH * CDK + i];
        float p = 1.0f / (1.0f + __expf(l0 - l1));
        LB[i] = fminf(fmaxf(p, 0.f), 1.f);
    }
}

__device__ __forceinline__ void conva_rows(const bf16* PROJ, bf16* MIXED, const float* cw, size_t row0, int nrows, bool have_prev, const float* prev_state, float* state_out, int lane) {
    const int c = lane * 8;
    float w0[8], w1[8], w2[8], um2[8], um1[8];
#pragma unroll
    for (int i = 0; i < 8; ++i) { w0[i] = cw[c + i]; w1[i] = cw[AW + c + i]; w2[i] = cw[2 * AW + c + i]; um2[i] = 0.f; um1[i] = 0.f; }
    if (prev_state) {
#pragma unroll
        for (int i = 0; i < 8; ++i) { um2[i] = prev_state[c + i]; um1[i] = prev_state[AW + c + i]; }
    } else if (have_prev) {
        const v4u h2 = *(const v4u*)(PROJ + (row0 - 2) * DINAB + C_H + c), g2 = *(const v4u*)(PROJ + (row0 - 2) * DINAB + C_GC + c);
        const v4u h1 = *(const v4u*)(PROJ + (row0 - 1) * DINAB + C_H + c), g1 = *(const v4u*)(PROJ + (row0 - 1) * DINAB + C_GC + c);
#pragma unroll
        for (int i = 0; i < 4; ++i) { um2[2 * i] = bflo(h2[i]) * bflo(g2[i]); um2[2 * i + 1] = bfhi(h2[i]) * bfhi(g2[i]); um1[2 * i] = bflo(h1[i]) * bflo(g1[i]); um1[2 * i + 1] = bfhi(h1[i]) * bfhi(g1[i]); }
    }
    const char* pb = (const char*)(PROJ + row0 * DINAB + c);
    char* ob = (char*)(MIXED + row0 * D + c);
    v4u hv[4], gbv[4], gcv[4];
#pragma unroll
    for (int p = 0; p < 4; ++p) { const char* pr = pb + (size_t)p * DINAB * 2; hv[p] = *(const v4u*)(pr + C_H * 2); gbv[p] = *(const v4u*)(pr + C_GB * 2); gcv[p] = *(const v4u*)(pr + C_GC * 2); }
    for (int r4 = 0; r4 < nrows; r4 += 4) {
        v4u hn[4], gbn[4], gcn[4];
        { const int rn = (r4 + 4 < nrows) ? r4 + 4 : r4;
#pragma unroll
          for (int p = 0; p < 4; ++p) { const char* pr = pb + (size_t)(rn + p) * DINAB * 2; hn[p] = *(const v4u*)(pr + C_H * 2); gbn[p] = *(const v4u*)(pr + C_GB * 2); gcn[p] = *(const v4u*)(pr + C_GC * 2); } }
#pragma unroll
        for (int p = 0; p < 4; ++p) {
            float u[8], y[8];
#pragma unroll
            for (int i = 0; i < 4; ++i) { u[2 * i] = bflo(hv[p][i]) * bflo(gcv[p][i]); u[2 * i + 1] = bfhi(hv[p][i]) * bfhi(gcv[p][i]); }
#pragma unroll
            for (int i = 0; i < 8; ++i) y[i] = w0[i] * um2[i] + w1[i] * um1[i] + w2[i] * u[i];
            v4u o;
#pragma unroll
            for (int i = 0; i < 4; ++i) o[i] = pk2(bflo(gbv[p][i]) * y[2 * i], bfhi(gbv[p][i]) * y[2 * i + 1]);
            *(v4u*)(ob + (size_t)(r4 + p) * D * 2) = o;
#pragma unroll
            for (int i = 0; i < 8; ++i) { um2[i] = um1[i]; um1[i] = u[i]; }
        }
#pragma unroll
        for (int p = 0; p < 4; ++p) { hv[p] = hn[p]; gbv[p] = gbn[p]; gcv[p] = gcn[p]; }
    }
    if (state_out) {
#pragma unroll
        for (int i = 0; i < 8; ++i) { state_out[c + i] = um2[i]; state_out[AW + c + i] = um1[i]; }
    }
}

constexpr int AT_KS = 0, AT_VT = 36864, AT_LINV = AT_VT + 33792, AT_OST = AT_LINV + 1024;
__device__ __forceinline__ void attn_prompt_unit(const Ctx& F, const bf16* PROJ, bf16* MIXED, int u) {
    const int tid = F.tid, lane = F.lane, wave = F.wave;
    const int kvh = u & 1, qb = (u >> 1) & 31, b = u >> 6;
    const long rowq0 = (long)b * SEQ + (long)qb * 128;
    LAS unsigned char* Ks = F.lds + AT_KS;
    LAS unsigned char* Vt = F.lds + AT_VT;
    LAS float* linv = (LAS float*)(F.lds + AT_LINV) + wave * 32;
    { unsigned z = 0u; asm volatile("" : "+v"(z));
      const char* kbase = (const char*)PROJ + ((rowq0 - 128) * DINAB + C_K + kvh * HD) * 2;
      const unsigned koff = (unsigned)(((tid >> 3) * DINAB + (tid & 7) * 8) * 2);
#pragma unroll
      for (int i = 0; i < 4; ++i) {
        v4u val = (v4u){z, z, z, z};
        if (qb > 0 || i >= 2) val = *(const v4u*)(kbase + (long)i * 64 * DINAB * 2 + koff);
        *(LAS v4u*)(Ks + ((tid >> 3) + 64 * i) * 144 + (tid & 7) * 16) = val;
      }
      const char* vbase = (const char*)PROJ + ((rowq0 - 128) * DINAB + C_V + kvh * HD) * 2;
      const unsigned voff = (unsigned)(((tid & 255) * DINAB + (tid >> 8) * 8) * 2);
      const int key = tid & 255;
#pragma unroll
      for (int i = 0; i < 4; ++i) {
        v4u val = (v4u){z, z, z, z};
        if (qb > 0 || key >= 128) val = *(const v4u*)(vbase + i * 32 + voff);
        const int dc = (tid >> 8) + 2 * i;
#pragma unroll
        for (int j = 0; j < 8; ++j) *(LAS unsigned short*)(Vt + (dc * 8 + j) * 528 + key * 2) = (unsigned short)(val[j >> 1] >> (16 * (j & 1)));
      }
    }
    __syncthreads();
    const int g = wave >> 1, qhalf = wave & 1, head = kvh * 4 + g;
    const float slope2 = ex2(-(float)(head + 1)) * LOG2E, sink2 = F.in[13][head] * LOG2E, sc2 = 0.125f * LOG2E;
    const int qi = lane & 31, hi = lane >> 5;
#pragma unroll 1
    for (int qblk = 0; qblk < 2; ++qblk) {
        const int q0 = qhalf * 64 + qblk * 32;
        const char* qbase = (const char*)PROJ + ((rowq0 + q0) * DINAB + C_Q + head * HD) * 2;
        const unsigned qoff = (unsigned)((qi * DINAB + 8 * hi) * 2);
        bf16x8 qf[4];
#pragma unroll
        for (int ks = 0; ks < 4; ++ks) qf[ks] = *(const bf16x8*)(qbase + ks * 32 + qoff);
        f32x16 o0 = {0.f, 0.f, 0.f, 0.f, 0.f, 0.f, 0.f, 0.f, 0.f, 0.f, 0.f, 0.f, 0.f, 0.f, 0.f, 0.f}, o1 = o0;
        float mx = sink2, l = 0.f;
#pragma unroll 1
        for (int kt = 0; kt < 5; ++kt) {
            f32x16 st = {0.f, 0.f, 0.f, 0.f, 0.f, 0.f, 0.f, 0.f, 0.f, 0.f, 0.f, 0.f, 0.f, 0.f, 0.f, 0.f};
            const LAS unsigned char* kp = Ks + (q0 + 32 * kt + qi) * 144 + 16 * hi;
#pragma unroll
            for (int ks = 0; ks < 4; ++ks) {
                const bf16x8 kf = *(const LAS bf16x8*)(kp + 32 * ks);
                st = __builtin_amdgcn_mfma_f32_32x32x16_bf16(kf, qf[ks], st, 0, 0, 0);
            }
            float tmx = mx;
#pragma unroll
            for (int r = 0; r < 16; ++r) {
                const int crow = (r & 3) + 8 * (r >> 2) + 4 * hi;
                const int dist = 128 + qi - 32 * kt - crow;
                const bool valid = (dist >= 0) && (dist < WIN) && (qb > 0 || (q0 + 32 * kt + crow) >= 128);
                const float x = valid ? (st[r] * sc2 - slope2 * (float)dist) : -INFINITY;
                st[r] = x; tmx = fmaxf(tmx, x);
            }
            tmx = fmaxf(tmx, shx(tmx, 32, lane));
            const float alpha = ex2(mx - tmx); mx = tmx;
            linv[qi] = alpha;
            LDS_WAIT();
            float ps = 0.f;
#pragma unroll
            for (int r = 0; r < 16; ++r) { const float p = ex2(st[r] - mx); st[r] = p; ps += p; }
            ps += shx(ps, 32, lane);
            l = l * alpha + ps;
#pragma unroll
            for (int r = 0; r < 16; ++r) { const float al = linv[(r & 3) + 8 * (r >> 2) + 4 * hi]; o0[r] *= al; o1[r] *= al; }
            LDS_WAIT();
#pragma unroll
            for (int s = 0; s < 2; ++s) {
                v4u pw;
#pragma unroll
                for (int j = 0; j < 4; ++j) pw[j] = pk2(st[8 * s + 2 * j], st[8 * s + 2 * j + 1]);
                const bf16x8 pa = __builtin_bit_cast(bf16x8, pw);
                const LAS unsigned char* vp = Vt + qi * 528 + (q0 + 32 * kt + 16 * s + 4 * hi) * 2;
                const v2u a0 = *(const LAS v2u*)(vp), a1 = *(const LAS v2u*)(vp + 16);
                const v2u b0 = *(const LAS v2u*)(vp + 32 * 528), b1 = *(const LAS v2u*)(vp + 32 * 528 + 16);
                const bf16x8 vb0 = __builtin_bit_cast(bf16x8, (v4u){a0.x, a0.y, a1.x, a1.y});
                const bf16x8 vb1 = __builtin_bit_cast(bf16x8, (v4u){b0.x, b0.y, b1.x, b1.y});
                o0 = __builtin_amdgcn_mfma_f32_32x32x16_bf16(pa, vb0, o0, 0, 0, 0);
                o1 = __builtin_amdgcn_mfma_f32_32x32x16_bf16(pa, vb1, o1, 0, 0, 0);
            }
        }
        l += ex2(sink2 - mx);
        linv[qi] = 1.0f / l;
        LDS_WAIT();
        LAS unsigned char* ost = F.lds + AT_OST + wave * 4608;
#pragma unroll
        for (int r = 0; r < 16; ++r) {
            const int crow = (r & 3) + 8 * (r >> 2) + 4 * hi;
            const float li = linv[crow];
            *(LAS unsigned short*)(ost + crow * 144 + qi * 2) = (unsigned short)f2bf(o0[r] * li);
            *(LAS unsigned short*)(ost + crow * 144 + 64 + qi * 2) = (unsigned short)f2bf(o1[r] * li);
        }
        LDS_WAIT();
        { const int orow = lane >> 1, ohalf = lane & 1;
          char* op = (char*)MIXED + ((rowq0 + q0 + orow) * D + AW + head * HD + 32 * ohalf) * 2;
#pragma unroll
          for (int j = 0; j < 4; ++j) *(v4u*)(op + 16 * j) = *(const LAS v4u*)(ost + orow * 144 + 64 * ohalf + 16 * j); }
        LDS_WAIT();
    }
    __syncthreads();
}

constexpr int SA_KS = 68;
constexpr int SA_K = 0, SA_V = SA_K + 132 * SA_KS * 4, SA_Q = SA_V + 132 * 64 * 4, SA_P = SA_Q + 16 * 64 * 4, SA_PS = 136, SA_O = SA_P + 16 * SA_PS * 4;
__device__ __forceinline__ void attn_sample_item(const Ctx& F, const bf16* PROJ, bf16* MIXED, int item) {
    const int tid = F.tid, lane = F.lane, wave = F.wave;
    const int s = item >> 1, kvh = item & 1;
    const size_t rs = (size_t)MP + (size_t)s * NS;
    LAS float* Kc = (LAS float*)(F.lds + SA_K); LAS float* Vc = (LAS float*)(F.lds + SA_V); LAS float* Qs = (LAS float*)(F.lds + SA_Q); LAS float* P = (LAS float*)(F.lds + SA_P); LAS float* Op = (LAS float*)(F.lds + SA_O);
    const float* ck = F.in[3] + (size_t)s * WIN * NKV * HD + kvh * HD; const float* cv = F.in[4] + (size_t)s * WIN * NKV * HD + kvh * HD;
    float* ok = F.out + O_KS + (size_t)s * WIN * NKV * HD + kvh * HD; float* ov = F.out + O_VS + (size_t)s * WIN * NKV * HD + kvh * HD;
#pragma unroll
    for (int i = 0; i < 4; ++i) {
        const int idx = tid + 512 * i, j = idx >> 4, d4 = idx & 15;
        const f32x4 kk = *(const f32x4*)(ck + (size_t)j * NKV * HD + 4 * d4), vv = *(const f32x4*)(cv + (size_t)j * NKV * HD + 4 * d4);
        *(LAS f32x4*)(Kc + j * SA_KS + 4 * d4) = kk; *(LAS f32x4*)(Vc + j * 64 + 4 * d4) = vv;
        if (j >= NS) { *(f32x4*)(ok + (size_t)(j - NS) * NKV * HD + 4 * d4) = kk; *(f32x4*)(ov + (size_t)(j - NS) * NKV * HD + 4 * d4) = vv; }
    }
    if (tid < 256) {
        const int t = tid >> 6, d = tid & 63;
        const float kk = bf2f(PROJ[(rs + t) * DINAB + C_K + kvh * HD + d]), vv = bf2f(PROJ[(rs + t) * DINAB + C_V + kvh * HD + d]);
        Kc[(WIN + t) * SA_KS + d] = kk; Vc[(WIN + t) * 64 + d] = vv;
        ok[(size_t)(WIN - NS + t) * NKV * HD + d] = kk; ov[(size_t)(WIN - NS + t) * NKV * HD + d] = vv;
    }
    for (int idx = tid; idx < 16 * 64; idx += 512) {
        const int r = idx >> 6, d = idx & 63, g = r >> 2, t = r & 3;
        Qs[idx] = bf2f(PROJ[(rs + t) * DINAB + C_Q + (kvh * 4 + g) * HD + d]);
    }
    __syncthreads();
    for (int p = tid; p < 16 * 132; p += 512) {
        const int r = p / 132, j = p - r * 132, g = r >> 2, t = r & 3;
        const int dist = WIN + t - j;
        float acc = 0.f;
#pragma unroll
        for (int d4 = 0; d4 < 16; ++d4) { const f32x4 q4 = *(const LAS f32x4*)(Qs + r * 64 + 4 * d4), k4 = *(const LAS f32x4*)(Kc + j * SA_KS + 4 * d4); acc += (q4.x * k4.x + q4.y * k4.y) + (q4.z * k4.z + q4.w * k4.w); }
        const float slope = ex2(-(float)(kvh * 4 + g + 1));
        P[r * SA_PS + j] = (dist >= 0 && dist < WIN) ? (acc * 0.125f - slope * (float)dist) : -INFINITY;
    }
    __syncthreads();
#pragma unroll
    for (int rr = 0; rr < 2; ++rr) {
        const int r = wave * 2 + rr, g = r >> 2;
        const float sink = F.in[13][kvh * 4 + g];
        float v0 = P[r * SA_PS + lane], v1 = P[r * SA_PS + 64 + lane], v2 = lane < 4 ? P[r * SA_PS + 128 + lane] : -INFINITY;
        float mx = fmaxf(fmaxf(v0, v1), fmaxf(v2, sink));
#pragma unroll
        for (int o = 1; o < 64; o <<= 1) mx = fmaxf(mx, shx(mx, o, lane));
        v0 = fexp(v0 - mx); v1 = fexp(v1 - mx); v2 = fexp(v2 - mx);
        const float den = wave_sum(v0 + v1 + v2, lane) + fexp(sink - mx);
        const float inv = 1.0f / den;
        P[r * SA_PS + lane] = v0 * inv; P[r * SA_PS + 64 + lane] = v1 * inv; if (lane < 4) P[r * SA_PS + 128 + lane] = v2 * inv;
    }
    __syncthreads();
    {
      const int jh = tid >> 8, r = (tid >> 4) & 15, d4 = tid & 15;
      f32x4 acc = {0.f, 0.f, 0.f, 0.f};
#pragma unroll 6
      for (int jj = 0; jj < 66; ++jj) { const int j = jh * 66 + jj; const float pw = P[r * SA_PS + j]; const f32x4 v4 = *(const LAS f32x4*)(Vc + j * 64 + 4 * d4); acc = acc + v4 * pw; }
      if (jh == 1) *(LAS f32x4*)(Op + r * 64 + 4 * d4) = acc;
      __syncthreads();
      if (jh == 0) {
          const f32x4 o2 = *(const LAS f32x4*)(Op + r * 64 + 4 * d4); acc = acc + o2;
          const int g = r >> 2, t = r & 3;
          *(v2u*)(MIXED + (rs + t) * D + AW + (kvh * 4 + g) * HD + 4 * d4) = (v2u){pk2(acc.x, acc.y), pk2(acc.z, acc.w)};
      }
    }
    __syncthreads();
}

__device__ __forceinline__ void phase_mixer_ab(const Ctx& F0) {
    const bf16* PROJ = (const bf16*)(F0.ws + WS_BR); bf16* MIXED = (bf16*)(F0.ws + WS_ACT1);
    for (int u = F0.vcu; u < BATCH * 32 * NKV; u += F0.G) attn_prompt_unit(F0, PROJ, MIXED, u);
    const Ctx F1 = reopaque(F0);
    for (int it = F1.vcu; it < NB * NKV; it += F1.G) attn_sample_item(F1, PROJ, MIXED, it);
    const Ctx F = reopaque(F1);
    const int gw = F.vcu * NWAVES + F.wave, NGW = F.G * NWAVES;
    for (int it = gw; it < MP / 16; it += NGW) {
        const int b = it >> 8, r0 = (it & 255) * 16;
        conva_rows(PROJ, MIXED, F.in[12], (size_t)b * SEQ + r0, 16, r0 > 0, nullptr, r0 == SEQ - 16 ? F.out + O_CAP + (size_t)b * 2 * AW : nullptr, F.lane);
    }
    for (int it = gw; it < NB; it += NGW)
        conva_rows(PROJ, MIXED, F.in[12], (size_t)MP + (size_t)it * NS, NS, false, F.in[2] + (size_t)it * 2 * AW, F.out + O_CAS + (size_t)it * 2 * AW, F.lane);
    for (int i = F.vcu * 512 + F.tid; i < 2 * BATCH * WIN * NKV * HD; i += F.G * 512) {
        const int which = i / (BATCH * WIN * NKV * HD), e = i - which * (BATCH * WIN * NKV * HD);
        const int b = e / (WIN * NKV * HD), rem = e - b * (WIN * NKV * HD), j = rem / (NKV * HD), c = rem - j * (NKV * HD);
        const float v = bf2f(PROJ[((size_t)b * SEQ + SEQ - WIN + j) * DINAB + (which ? C_V : C_K) + c]);
        F.out[(which ? O_VP : O_KP) + e] = v;
    }
}

template <int MODE>
__device__ __forceinline__ void phase_rowwise(const Ctx& F, const bf16* src, const float* gpost) {
    const int gw = F.vcu * NWAVES + F.wave, NGW = F.G * NWAVES, lane = F.lane;
    bf16* XB = (bf16*)(F.ws + WS_XB); float* RS = (float*)(F.ws + WS_RS);
    f32x4 gp[4];
#pragma unroll
    for (int j = 0; j < 4; ++j) gp[j] = ((const f32x4*)gpost)[64 * j + lane];
    v2u sw[3][4]; f32x4 xf[3][4]; v2u xw[3][4];
#define RW_LOAD(slot, mm) do { const int m_ = (mm) < MT ? (mm) : MT - 1; const float* xr_ = m_ < MP ? F.in[0] + (size_t)m_ * D : F.in[1] + (size_t)(m_ - MP) * D; \
        _Pragma("unroll") for (int j = 0; j < 4; ++j) { sw[slot][j] = ((const v2u*)(src + (size_t)m_ * D))[64 * j + lane]; \
            if (MODE == 0) xf[slot][j] = ((const f32x4*)xr_)[64 * j + lane]; else xw[slot][j] = ((const v2u*)(XB + (size_t)m_ * D))[64 * j + lane]; } } while (0)
    RW_LOAD(0, gw); RW_LOAD(1, gw + NGW);
    for (int m = gw; m < MT; m += NGW) {
        RW_LOAD(2, m + 2 * NGW);
        f32x4 v[4], xv[4]; float s = 0.f;
#pragma unroll
        for (int j = 0; j < 4; ++j) { v[j] = (f32x4){bflo(sw[0][j].x), bfhi(sw[0][j].x), bflo(sw[0][j].y), bfhi(sw[0][j].y)};
            xv[j] = (MODE == 0) ? xf[0][j] : (f32x4){bflo(xw[0][j].x), bfhi(xw[0][j].x), bflo(xw[0][j].y), bfhi(xw[0][j].y)};
            s += (v[j].x * v[j].x + v[j].y * v[j].y) + (v[j].z * v[j].z + v[j].w * v[j].w); }
        const float r = __builtin_amdgcn_rsqf(wave_sum(s, lane) * (1.f / D) + EPS);
        float s2 = 0.f;
#pragma unroll
        for (int j = 0; j < 4; ++j) {
            xv[j] = xv[j] + v[j] * r * gp[j]; s2 += (xv[j].x * xv[j].x + xv[j].y * xv[j].y) + (xv[j].z * xv[j].z + xv[j].w * xv[j].w);
            if (MODE == 2) ((f32x4*)(F.out + (size_t)m * D))[64 * j + lane] = xv[j];
            else ((unsigned long long*)(XB + (size_t)m * D))[64 * j + lane] = (unsigned long long)pk2(xv[j].x, xv[j].y) | ((unsigned long long)pk2(xv[j].z, xv[j].w) << 32); }
        if (MODE != 2) { const float r2 = __builtin_amdgcn_rsqf(wave_sum(s2, lane) * (1.f / D) + EPS); if (lane == 0) RS[m] = r2; }
#pragma unroll
        for (int j = 0; j < 4; ++j) { sw[0][j] = sw[1][j]; sw[1][j] = sw[2][j];
            if (MODE == 0) { xf[0][j] = xf[1][j]; xf[1][j] = xf[2][j]; } else { xw[0][j] = xw[1][j]; xw[1][j] = xw[2][j]; } }
    }
#undef RW_LOAD
}

__device__ __forceinline__ float gelu_tanh(float y) {
    const float z2 = 1.5957691216057308f * (y + 0.044715f * y * y * y);
    return y * __builtin_amdgcn_rcpf(1.0f + fexp(-z2));
}
__device__ __forceinline__ void phase_ffnfix(const Ctx& F, int layer) {
    bf16* G = (bf16*)(F.ws + WS_BR);
    const float* cw = F.in[20] + (size_t)layer * 3 * DFF;
    const float* HALO = (const float*)(F.ws + WS_HALO); const float* A01 = (const float*)(F.ws + WS_A01); const float* B01 = (const float*)(F.ws + WS_B01);
    for (int idx = F.vcu * 512 + F.tid; idx < 120 * DFF; idx += F.G * 512) {
        const int t = idx / DFF, c = idx - t * DFF, pm = (t / 15) * 16 + 1 + (t % 15);
        const float h0 = HALO[(size_t)((pm - 1) * 2) * DFF + c], h1 = HALO[(size_t)((pm - 1) * 2 + 1) * DFF + c];
        const float a0 = A01[(size_t)(pm * 2) * DFF + c], a1 = A01[(size_t)(pm * 2 + 1) * DFF + c];
        const float b0 = B01[(size_t)(pm * 2) * DFF + c], b1 = B01[(size_t)(pm * 2 + 1) * DFF + c];
        const float w0 = cw[c], w1 = cw[DFF + c], w2 = cw[2 * DFF + c];
        G[(size_t)(pm * 256) * DFF + c] = (bf16)f2bf(gelu_tanh(w0 * h0 + w1 * h1 + w2 * a0) * b0);
        G[(size_t)(pm * 256 + 1) * DFF + c] = (bf16)f2bf(gelu_tanh(w0 * h1 + w1 * a0 + w2 * a1) * b1);
    }
}

constexpr int GL_QT = 0, GL_KD = 17408, GL_Q0 = 34816, GL_KO = 43520, GL_KHT = 52224, GL_VT = 70656, GL_AM = 89088, GL_ST = 98304, GL_TX = 133120, GL_DEC = 135168, GL_END = 135680;
constexpr int GL_OS = 0;
static_assert(GL_END <= LDSCTL_OFF, "GLA LDS map");
__device__ __forceinline__ void gla_finish_row(const f32x4 (&ov)[4], const v4u gate0, const v4u gate1, const float (&gn)[16], char* op, int lane) {
    float ss = 0.f;
#pragma unroll
    for (int j = 0; j < 4; ++j) ss += (ov[j].x * ov[j].x + ov[j].y * ov[j].y) + (ov[j].z * ov[j].z + ov[j].w * ov[j].w);
    ss += shx(ss, 1, lane); ss += shx(ss, 2, lane); ss += shx(ss, 4, lane);
    const float rn = __builtin_amdgcn_rsqf(ss * (1.f / CDV) + EPS);
    const unsigned gw_[8] = {gate0.x, gate0.y, gate0.z, gate0.w, gate1.x, gate1.y, gate1.z, gate1.w};
    unsigned ow[8];
#pragma unroll
    for (int j = 0; j < 8; ++j) {
        const float g0 = bflo(gw_[j]), g1 = bfhi(gw_[j]);
        const float s0 = g0 * __builtin_amdgcn_rcpf(1.0f + fexp(-g0)), s1 = g1 * __builtin_amdgcn_rcpf(1.0f + fexp(-g1));
        const float n0 = gn[2 * j], n1 = gn[2 * j + 1];
        ow[j] = pk2(ov[j >> 1][(2 * j) & 3] * rn * n0 * s0, ov[j >> 1][(2 * j + 1) & 3] * rn * n1 * s1);
    }
    *(v4u*)op = (v4u){ow[0], ow[1], ow[2], ow[3]}; *(v4u*)(op + 16) = (v4u){ow[4], ow[5], ow[6], ow[7]};
}
__device__ __forceinline__ void gla_prompt_item(const Ctx& F, const bf16* PROJ, bf16* OUT, int item) {
    int lane = F.lane; asm volatile("" : "+v"(lane));
    const int wave = F.wave, tid = wave * 64 + lane;
    const int b = item >> 5, h = (item >> 2) & 7, seg = item & 3;
    LAS unsigned char* L = F.lds;
    const int d = tid & 127, qi = tid >> 7;
    const int l31 = lane & 31, hi = lane >> 5, l15 = lane & 15, l4 = lane >> 4;
    { unsigned z = 0u; asm volatile("" : "+v"(z));
      for (int i = tid; i < (GL_ST + 34816 - GL_AM) / 16; i += 512) *(LAS v4u*)(L + GL_AM + i * 16) = (v4u){z, z, z, z}; }
    f32x16 Sa = {0.f, 0.f, 0.f, 0.f, 0.f, 0.f, 0.f, 0.f, 0.f, 0.f, 0.f, 0.f, 0.f, 0.f, 0.f, 0.f}, Sb = Sa;
    const int vi = wave & 3, dkA = 2 * (wave >> 2), ti2 = wave >> 2;
    const float* gnorm = F.in[17];
    const long rowb = (long)b * SEQ + (long)seg * SEGL;
    const long crowb = (long)b * 3 * SEGL + (long)(seg - 1) * SEGL;
    const char* pbase = (const char*)PROJ + (rowb * DINC + h * CDK) * 2;
    const __amdgpu_buffer_rsrc_t prs = __builtin_amdgcn_make_buffer_rsrc((void*)pbase, 0, 0x7fffffff, 0x00020000);
    const __amdgpu_buffer_rsrc_t qrs = __builtin_amdgcn_make_buffer_rsrc((void*)((char*)F.out + OQ_QSEG + (crowb * D + h * CDK) * 2), 0, seg > 0 ? SEGL * D * 2 : 0, 0x00020000);
    const int ctok = tid >> 4, cdc = tid & 15;
    const int cvoff = (ctok * DINC + cdc * 8) * 2, cloff = ctok * 272 + cdc * 16;
    constexpr int GL_RAW = GL_Q0;
    v4u R[3][2];
#pragma unroll
    for (int T = 0; T < 3; ++T)
#pragma unroll
        for (int p = 0; p < 2; ++p) R[T][p] = __builtin_bit_cast(v4u, __builtin_amdgcn_raw_buffer_load_b128(prs, cvoff, (p * 32 * DINC + T * 1024) * 2, 0));
    const int et = tid >> 3, eseg = tid & 7;
    float gn[16];
#pragma unroll
    for (int j = 0; j < 16; ++j) gn[j] = gnorm[16 * eseg + j];
    const int goff = (et * DINC + 16 * eseg) * 2; const unsigned ooff = (unsigned)((et * D + 16 * eseg) * 2);
    float Gacc = 0.f;
    const float lbd = ((const float*)(F.ws + WS_LB))[h * CDK + d], oml = 1.0f - lbd;
    float* eacc = (float*)((char*)F.out + OQ_EACC) + (size_t)item * 16 * CDK;
    __syncthreads();
    for (int c = 0; c < SEGL / GCH; ++c) {
#pragma unroll
        for (int T = 0; T < 3; ++T)
#pragma unroll
            for (int p = 0; p < 2; ++p) *(LAS v4u*)(L + GL_RAW + T * 17408 + p * 32 * 272 + cloff) = R[T][p];
        __syncthreads();
        unsigned short qv[16], lv[16], vv[16];
#pragma unroll
        for (int t = 0; t < 16; ++t) { const LAS unsigned char* rp = L + GL_RAW + (16 * qi + t) * 272 + d * 2;
            qv[t] = *(const LAS unsigned short*)rp; lv[t] = *(const LAS unsigned short*)(rp + 17408); vv[t] = *(const LAS unsigned short*)(rp + 2 * 17408); }
        float cs[16], kf[16];
        { float run = 0.f;
#pragma unroll
          for (int t = 0; t < 16; ++t) { const float f = __builtin_fmaf(oml, __builtin_amdgcn_rcpf(1.0f + fexp(-bf2f(lv[t]))), lbd); kf[t] = 1.0f - f; run += __builtin_amdgcn_logf(f); cs[t] = run; } }
        ((LAS float*)(L + GL_TX))[qi * 128 + d] = cs[15];
        __syncthreads();
        const float T0 = ((LAS float*)(L + GL_TX))[d], T1 = ((LAS float*)(L + GL_TX))[128 + d], T2 = ((LAS float*)(L + GL_TX))[256 + d], T3 = ((LAS float*)(L + GL_TX))[384 + d];
        const float B1 = T0 + T1, Gend = B1 + T2 + T3;
        const float base32 = (qi >= 2) ? B1 : 0.f;
        const float add16 = (qi == 1) ? T0 : ((qi == 3) ? T2 : 0.f);
        { v4u kh[2], vt[2];
          const float EB1 = ex2(B1), EGR = ex2(Gend - base32);
          LAS unsigned char* xdst = (qi >= 2) ? (L + GL_Q0 + (16 * qi - 32) * 272 + d * 2) : (L + GL_KO + (16 * qi) * 272 + d * 2);
#pragma unroll
          for (int t = 0; t < 16; ++t) {
            const float c32 = fmaxf(cs[t] + add16, -115.f);
            const float q = bf2f(qv[t]), k = kf[t];
            const float e1 = ex2(c32), e1i = __builtin_amdgcn_rcpf(e1);
            const float qt = q * e1, kd = k * e1i;
            const int row = 16 * qi + t;
            *(LAS unsigned short*)(L + GL_QT + row * 272 + d * 2) = (unsigned short)f2bf(qt);
            *(LAS unsigned short*)(L + GL_KD + row * 272 + d * 2) = (unsigned short)f2bf(kd);
            *(LAS unsigned short*)(xdst + t * 272) = (unsigned short)f2bf(((qi >= 2) ? qt : kd) * EB1);
            const unsigned khb = f2bf(kd * EGR);
            if (t & 1) { kh[t >> 3][(t & 7) >> 1] |= khb << 16; vt[t >> 3][(t & 7) >> 1] |= ((unsigned)vv[t]) << 16; }
            else       { kh[t >> 3][(t & 7) >> 1] = khb;        vt[t >> 3][(t & 7) >> 1] = (unsigned)vv[t]; }
            if ((t & 3) == 3) __builtin_amdgcn_sched_barrier(0);
          }
          *(LAS v4u*)(L + GL_KHT + d * 144 + (16 * qi) * 2) = kh[0]; *(LAS v4u*)(L + GL_KHT + d * 144 + (16 * qi + 8) * 2) = kh[1];
          *(LAS v4u*)(L + GL_VT + d * 144 + (16 * qi) * 2) = vt[0];  *(LAS v4u*)(L + GL_VT + d * 144 + (16 * qi + 8) * 2) = vt[1];
          if (qi == 0) { ((LAS float*)(L + GL_DEC))[d] = ex2(Gend); eacc[c * CDK + d] = ex2(Gacc); }
          Gacc += Gend;
        }
        { const int cn = (c + 1 < SEGL / GCH) ? c + 1 : c;
#pragma unroll
          for (int T = 0; T < 3; ++T)
#pragma unroll
              for (int p = 0; p < 2; ++p) R[T][p] = __builtin_bit_cast(v4u, __builtin_amdgcn_raw_buffer_load_b128(prs, cvoff, ((cn * GCH + p * 32) * DINC + T * 1024) * 2, 0)); }
        const v4u gate0 = __builtin_bit_cast(v4u, __builtin_amdgcn_raw_buffer_load_b128(prs, goff, (c * GCH * DINC + C1_G) * 2, 0));
        const v4u gate1 = __builtin_bit_cast(v4u, __builtin_amdgcn_raw_buffer_load_b128(prs, goff, (c * GCH * DINC + C1_G) * 2 + 16, 0));
        __syncthreads();
#pragma unroll
        for (int p = 0; p < 2; ++p) {
            const v4u qw = *(const LAS v4u*)(L + (p ? GL_Q0 : GL_QT) + cloff);
            __builtin_amdgcn_raw_buffer_store_b128(__builtin_bit_cast(__attribute__((__vector_size__(4 * sizeof(unsigned)))) unsigned, qw), qrs, (ctok * D + cdc * 8) * 2, ((c * GCH + p * 32) * D) * 2, 0);
        }
#pragma unroll
        for (int rep = 0; rep < 2; ++rep) {
            const int idx = wave + 8 * rep;
            if (idx < 10) {
                const int ti = idx < 1 ? 0 : (idx < 3 ? 1 : (idx < 6 ? 2 : 3));
                const int sj = idx - (ti * (ti + 1)) / 2;
                const bool same = (ti >> 1) == (sj >> 1);
                LAS unsigned char* kbse = same ? (L + GL_KD) : (L + GL_KO);
                f32x4 a = {0.f, 0.f, 0.f, 0.f};
#pragma unroll
                for (int ks = 0; ks < 4; ++ks) {
                    const bf16x8 af = *(const LAS bf16x8*)(L + GL_QT + (16 * ti + l15) * 272 + (32 * ks + 8 * l4) * 2);
                    const bf16x8 bf = *(const LAS bf16x8*)(kbse + (16 * sj + l15) * 272 + (32 * ks + 8 * l4) * 2);
                    a = __builtin_amdgcn_mfma_f32_16x16x32_bf16(af, bf, a, 0, 0, 0);
                }
#pragma unroll
                for (int r = 0; r < 4; ++r) {
                    const int tl = 4 * l4 + r;
                    const float v = (ti != sj || l15 <= tl) ? a[r] : 0.f;
                    *(LAS unsigned short*)(L + GL_AM + (16 * ti + tl) * 144 + (16 * sj + l15) * 2) = (unsigned short)f2bf(v);
                }
            }
        }
        __syncthreads();
        f32x16 o = {0.f, 0.f, 0.f, 0.f, 0.f, 0.f, 0.f, 0.f, 0.f, 0.f, 0.f, 0.f, 0.f, 0.f, 0.f, 0.f};
        bf16x8 vf[4];
#pragma unroll
        for (int ks = 0; ks < 4; ++ks) vf[ks] = *(const LAS bf16x8*)(L + GL_VT + (32 * vi + l31) * 144 + (16 * ks + 8 * hi) * 2);
#pragma unroll
        for (int ks = 0; ks < 4; ++ks) {
            const bf16x8 af = *(const LAS bf16x8*)(L + GL_AM + (32 * ti2 + l31) * 144 + (16 * ks + 8 * hi) * 2);
            o = __builtin_amdgcn_mfma_f32_32x32x16_bf16(af, vf[ks], o, 0, 0, 0);
        }
        { LAS unsigned char* qbase = ti2 ? (L + GL_Q0) : (L + GL_QT);
#pragma unroll
          for (int ks = 0; ks < 8; ++ks) {
            const bf16x8 af = *(const LAS bf16x8*)(qbase + l31 * 272 + (16 * ks + 8 * hi) * 2);
            const bf16x8 sf = *(const LAS bf16x8*)(L + GL_ST + (32 * vi + l31) * 272 + (16 * ks + 8 * hi) * 2);
            o = __builtin_amdgcn_mfma_f32_32x32x16_bf16(af, sf, o, 0, 0, 0);
          } }
#pragma unroll
        for (int r = 0; r < 16; ++r) {
            const int crow = (r & 3) + 8 * (r >> 2) + 4 * hi;
            Sa[r] *= ((LAS float*)(L + GL_DEC))[32 * dkA + crow]; Sb[r] *= ((LAS float*)(L + GL_DEC))[32 * dkA + 32 + crow];
        }
#pragma unroll
        for (int ks = 0; ks < 4; ++ks) {
            const bf16x8 ka = *(const LAS bf16x8*)(L + GL_KHT + (32 * dkA + l31) * 144 + (16 * ks + 8 * hi) * 2);
            const bf16x8 kb = *(const LAS bf16x8*)(L + GL_KHT + (32 * dkA + 32 + l31) * 144 + (16 * ks + 8 * hi) * 2);
            Sa = __builtin_amdgcn_mfma_f32_32x32x16_bf16(ka, vf[ks], Sa, 0, 0, 0);
            Sb = __builtin_amdgcn_mfma_f32_32x32x16_bf16(kb, vf[ks], Sb, 0, 0, 0);
        }
        __syncthreads();
#pragma unroll
        for (int g4 = 0; g4 < 4; ++g4) {
            *(LAS v2u*)(L + GL_ST + (32 * vi + l31) * 272 + (32 * dkA + 8 * g4 + 4 * hi) * 2) = (v2u){pk2(Sa[4 * g4], Sa[4 * g4 + 1]), pk2(Sa[4 * g4 + 2], Sa[4 * g4 + 3])};
            *(LAS v2u*)(L + GL_ST + (32 * vi + l31) * 272 + (32 * dkA + 32 + 8 * g4 + 4 * hi) * 2) = (v2u){pk2(Sb[4 * g4], Sb[4 * g4 + 1]), pk2(Sb[4 * g4 + 2], Sb[4 * g4 + 3])};
        }
#pragma unroll
        for (int r = 0; r < 16; ++r) {
            const int crow = (r & 3) + 8 * (r >> 2) + 4 * hi;
            ((LAS float*)(L + GL_OS))[(32 * ti2 + crow) * 132 + 32 * vi + l31] = o[r];
        }
        __syncthreads();
        { const LAS f32x4* orow = (const LAS f32x4*)(L + GL_OS + (et * 132 + 16 * eseg) * 4);
          f32x4 ov[4];
#pragma unroll
          for (int j = 0; j < 4; ++j) ov[j] = orow[j];
          if (seg == 0) gla_finish_row(ov, gate0, gate1, gn, (char*)OUT + ((rowb + (long)c * GCH) * D + h * CDV) * 2 + ooff, lane);
          else { char* op = (char*)F.out + OQ_OLOC + ((crowb + (long)c * GCH) * D + h * CDV) * 2 + ooff;
                 *(v4u*)op = (v4u){pk2(ov[0].x, ov[0].y), pk2(ov[0].z, ov[0].w), pk2(ov[1].x, ov[1].y), pk2(ov[1].z, ov[1].w)};
                 *(v4u*)(op + 16) = (v4u){pk2(ov[2].x, ov[2].y), pk2(ov[2].z, ov[2].w), pk2(ov[3].x, ov[3].y), pk2(ov[3].z, ov[3].w)}; }
        }
    }
    char* so = (char*)F.out + OQ_DS + ((size_t)item * CDK * CDV + (size_t)(32 * dkA) * CDV + 32 * vi) * 4;
    unsigned soff = (unsigned)((4 * hi * CDV + l31) * 4);
    asm volatile("" : "+v"(soff));
#pragma unroll
    for (int r = 0; r < 16; ++r) {
        const int crow0 = (r & 3) + 8 * (r >> 2);
        *(float*)(so + crow0 * CDV * 4 + soff) = Sa[r];
        *(float*)(so + (32 + crow0) * CDV * 4 + soff) = Sb[r];
    }
    if (qi == 0) ((float*)((char*)F.out + OQ_DD))[item * CDK + d] = ex2(Gacc);
    __syncthreads();
}

__device__ __forceinline__ void gla_fix_item(const Ctx& F, const bf16* PROJ, bf16* OUT, int item3) {
    const int tid = F.tid, lane = F.lane, wave = F.wave;
    const int bh = item3 / 3, seg = 1 + item3 - bh * 3, b = bh >> 3, h = bh & 7;
    LAS unsigned char* L = F.lds;
    const int l31 = lane & 31, hi = lane >> 5;
    const float* DS = (const float*)((const char*)F.out + OQ_DS); const float* DD = (const float*)((const char*)F.out + OQ_DD);
    const int dvt = tid & 127, dq = wave >> 1;
    float S[32];
#pragma unroll
    for (int i = 0; i < 32; ++i) S[i] = 0.f;
    for (int j = 0; j < seg; ++j) {
        const __amdgpu_buffer_rsrc_t rs = __builtin_amdgcn_make_buffer_rsrc((void*)(DS + (size_t)(bh * NSEG + j) * CDK * CDV), 0, CDK * CDV * 4, 0x00020000);
        const float* dd = DD + (bh * NSEG + j) * CDK + 32 * dq;
#pragma unroll
        for (int i = 0; i < 32; ++i) S[i] = dd[i] * S[i] + __builtin_bit_cast(float, __builtin_amdgcn_raw_buffer_load_b32(rs, dvt * 4, (32 * dq + i) * CDV * 4, 0));
    }
    if (seg == NSEG - 1) {
        const __amdgpu_buffer_rsrc_t rs = __builtin_amdgcn_make_buffer_rsrc((void*)(DS + (size_t)(bh * NSEG + seg) * CDK * CDV), 0, CDK * CDV * 4, 0x00020000);
        const __amdgpu_buffer_rsrc_t ro = __builtin_amdgcn_make_buffer_rsrc((void*)(F.out + O_HP + (size_t)bh * CDK * CDV), 0, CDK * CDV * 4, 0x00020000);
        const float* dd = DD + (bh * NSEG + seg) * CDK + 32 * dq;
#pragma unroll
        for (int i = 0; i < 32; ++i) {
            const float v = dd[i] * S[i] + __builtin_bit_cast(float, __builtin_amdgcn_raw_buffer_load_b32(rs, dvt * 4, (32 * dq + i) * CDV * 4, 0));
            __builtin_amdgcn_raw_buffer_store_b32(__builtin_bit_cast(unsigned, v), ro, dvt * 4, (32 * dq + i) * CDV * 4, 0);
        }
    }
    const int vi = wave & 3, ti2 = wave >> 2, et = tid >> 3, eseg = tid & 7;
    const long rowb = (long)b * SEQ + (long)seg * SEGL, crowb = (long)b * 3 * SEGL + (long)(seg - 1) * SEGL;
    const float* gnorm = F.in[17];
    const float* eacc = (const float*)((const char*)F.out + OQ_EACC) + (size_t)(bh * NSEG + seg) * 16 * CDK + 32 * dq;
    const char* qsb = (const char*)F.out + OQ_QSEG + (crowb * D + h * CDK) * 2;
    const char* olb = (const char*)F.out + OQ_OLOC + (crowb * D + h * CDV) * 2;
    const char* gtb = (const char*)PROJ + (rowb * DINC + C1_G + h * CDV) * 2;
    const unsigned aoff = (unsigned)(((32 * ti2 + l31) * D + 8 * hi) * 2), eoff = (unsigned)((et * D + 16 * eseg) * 2), goff = (unsigned)((et * DINC + 16 * eseg) * 2);
    float gn[16];
#pragma unroll
    for (int j = 0; j < 16; ++j) gn[j] = gnorm[16 * eseg + j];
    bf16x8 af[8]; v4u ol0, ol1, gate0, gate1;
#pragma unroll
    for (int ks = 0; ks < 8; ++ks) af[ks] = *(const bf16x8*)(qsb + ks * 32 + aoff);
    ol0 = *(const v4u*)(olb + eoff); ol1 = *(const v4u*)(olb + 16 + eoff); gate0 = *(const v4u*)(gtb + goff); gate1 = *(const v4u*)(gtb + 16 + goff);
#pragma unroll 1
    for (int c = 0; c < SEGL / GCH; ++c) {
        { const float* ea = eacc + c * CDK;
#pragma unroll
          for (int g = 0; g < 4; ++g) {
              float s8[8];
#pragma unroll
              for (int i = 0; i < 8; ++i) s8[i] = S[8 * g + i] * ea[8 * g + i];
              *(LAS v4u*)(L + GL_ST + dvt * 272 + (32 * dq + 8 * g) * 2) = (v4u){pk2(s8[0], s8[1]), pk2(s8[2], s8[3]), pk2(s8[4], s8[5]), pk2(s8[6], s8[7])};
          } }
        const int cn = (c + 1 < SEGL / GCH) ? c + 1 : c;
        bf16x8 afn[8];
#pragma unroll
        for (int ks = 0; ks < 8; ++ks) afn[ks] = *(const bf16x8*)(qsb + (long)cn * GCH * D * 2 + ks * 32 + aoff);
        const v4u ol0n = *(const v4u*)(olb + (long)cn * GCH * D * 2 + eoff), ol1n = *(const v4u*)(olb + (long)cn * GCH * D * 2 + 16 + eoff);
        const v4u gate0n = *(const v4u*)(gtb + (long)cn * GCH * DINC * 2 + goff), gate1n = *(const v4u*)(gtb + (long)cn * GCH * DINC * 2 + 16 + goff);
        __syncthreads();
        f32x16 o = {0.f, 0.f, 0.f, 0.f, 0.f, 0.f, 0.f, 0.f, 0.f, 0.f, 0.f, 0.f, 0.f, 0.f, 0.f, 0.f};
#pragma unroll
        for (int ks = 0; ks < 8; ++ks) {
            const bf16x8 sf = *(const LAS bf16x8*)(L + GL_ST + (32 * vi + l31) * 272 + (16 * ks + 8 * hi) * 2);
            o = __builtin_amdgcn_mfma_f32_32x32x16_bf16(af[ks], sf, o, 0, 0, 0);
        }
#pragma unroll
        for (int r = 0; r < 16; ++r) {
            const int crow = (r & 3) + 8 * (r >> 2) + 4 * hi;
            ((LAS float*)(L + GL_OS))[(32 * ti2 + crow) * 132 + 32 * vi + l31] = o[r];
        }
        __syncthreads();
        { const LAS f32x4* orow = (const LAS f32x4*)(L + GL_OS + (et * 132 + 16 * eseg) * 4);
          const unsigned olw[8] = {ol0.x, ol0.y, ol0.z, ol0.w, ol1.x, ol1.y, ol1.z, ol1.w};
          f32x4 ov[4];
#pragma unroll
          for (int j = 0; j < 4; ++j) { ov[j] = orow[j]; ov[j].x += bflo(olw[2 * j]); ov[j].y += bfhi(olw[2 * j]); ov[j].z += bflo(olw[2 * j + 1]); ov[j].w += bfhi(olw[2 * j + 1]); }
          gla_finish_row(ov, gate0, gate1, gn, (char*)OUT + ((rowb + (long)c * GCH) * D + h * CDV) * 2 + eoff, lane);
        }
#pragma unroll
        for (int ks = 0; ks < 8; ++ks) af[ks] = afn[ks];
        ol0 = ol0n; ol1 = ol1n; gate0 = gate0n; gate1 = gate1n;
    }
    __syncthreads();
}

constexpr int GS_Q = 0, GS_F = 2048, GS_K = 4096, GS_V = 6144, GS_OP = 8192, GS_O = GS_OP + 4 * 16 * 128 * 4, GS_G = GS_O + 2048;
constexpr int CW_DQ = 8192;
__device__ __forceinline__ int dequeue_item(const Ctx& F, gu32* ctr) {
    volatile LAS unsigned* slot = (volatile LAS unsigned*)(F.lds + MISC_OFF + 64);
    if (F.tid == 0) slot[0] = __hip_atomic_fetch_add(ctr, 1u, __ATOMIC_RELAXED, __HIP_MEMORY_SCOPE_AGENT);
    __syncthreads();
    const int v = (int)slot[0];
    __syncthreads();
    return __builtin_amdgcn_readfirstlane(v);
}
__device__ __forceinline__ void gla_sample_loop(const Ctx& F, const bf16* PROJ, bf16* OUT) {
    const int tid = F.tid;
    constexpr int NIT = NB * CH;
    gu32* ctr = (gu32*)(F.ws + WS_CTL) + CW_DQ;
    LAS float* Lq = (LAS float*)(F.lds + GS_Q); LAS float* Lf = (LAS float*)(F.lds + GS_F); LAS float* Lk = (LAS float*)(F.lds + GS_K); LAS float* Lv = (LAS float*)(F.lds + GS_V);
    LAS float* Lop = (LAS float*)(F.lds + GS_OP); LAS float* Lo = (LAS float*)(F.lds + GS_O); LAS float* Lg = (LAS float*)(F.lds + GS_G);
    const int dv4 = tid & 31, dkg = tid >> 5;
    const int svoff = (8 * dkg * CDV + 4 * dv4) * 4;
    int item = dequeue_item(F, ctr);
    if (item >= NIT) return;
    f32x4 S[8];
    { const __amdgpu_buffer_rsrc_t rs = __builtin_amdgcn_make_buffer_rsrc((void*)(F.in[5] + (size_t)item * CDK * CDV), 0, CDK * CDV * 4, 0x00020000);
#pragma unroll
      for (int i = 0; i < 8; ++i) S[i] = __builtin_bit_cast(f32x4, __builtin_amdgcn_raw_buffer_load_b128(rs, svoff, i * CDV * 4, 0)); }
    for (;;) {
        const int nxt = dequeue_item(F, ctr);
        const int nload = nxt < NIT ? nxt : NIT - 1;
        f32x4 Sn[8];
        { const __amdgpu_buffer_rsrc_t rs = __builtin_amdgcn_make_buffer_rsrc((void*)(F.in[5] + (size_t)nload * CDK * CDV), 0, CDK * CDV * 4, 0x00020000);
#pragma unroll
          for (int i = 0; i < 8; ++i) Sn[i] = __builtin_bit_cast(f32x4, __builtin_amdgcn_raw_buffer_load_b128(rs, svoff, i * CDV * 4, 0)); }
        const int s = item >> 3, h = item & 7;
        const size_t rs_ = (size_t)MP + (size_t)s * NS;
        { const int t = tid >> 7, d = tid & 127; const bf16* pr = PROJ + (rs_ + t) * DINC + h * CDK + d;
          const float lbd = ((const float*)(F.ws + WS_LB))[h * CDK + d]; const float f = __builtin_fmaf(1.0f - lbd, __builtin_amdgcn_rcpf(1.0f + fexp(-bf2f(pr[C1_F]))), lbd);
          Lq[tid] = bf2f(pr[C1_Q]); Lf[tid] = f; Lk[tid] = 1.0f - f; Lv[tid] = bf2f(pr[C1_I]); Lg[tid] = bf2f(pr[C1_G]); }
        __syncthreads();
#pragma unroll
        for (int t = 0; t < NS; ++t) {
            const f32x4 v4 = *(const LAS f32x4*)(Lv + t * 128 + 4 * dv4);
            f32x4 op = {0.f, 0.f, 0.f, 0.f};
#pragma unroll
            for (int g = 0; g < 2; ++g) {
                const f32x4 f4 = *(const LAS f32x4*)(Lf + t * 128 + 8 * dkg + 4 * g), k4 = *(const LAS f32x4*)(Lk + t * 128 + 8 * dkg + 4 * g), q4 = *(const LAS f32x4*)(Lq + t * 128 + 8 * dkg + 4 * g);
#pragma unroll
                for (int i = 0; i < 4; ++i) { S[4 * g + i] = S[4 * g + i] * f4[i] + v4 * k4[i]; op = op + S[4 * g + i] * q4[i]; }
            }
            *(LAS f32x4*)(Lop + (t * 16 + dkg) * 128 + 4 * dv4) = op;
        }
        { const __amdgpu_buffer_rsrc_t ro = __builtin_amdgcn_make_buffer_rsrc((void*)(F.out + O_HS + (size_t)item * CDK * CDV), 0, CDK * CDV * 4, 0x00020000);
#pragma unroll
          for (int i = 0; i < 8; ++i) __builtin_amdgcn_raw_buffer_store_b128(__builtin_bit_cast(__attribute__((__vector_size__(4 * sizeof(unsigned)))) unsigned, S[i]), ro, svoff, i * CDV * 4, 0); }
        __syncthreads();
        { const int t = tid >> 7, d = tid & 127;
          float o = 0.f;
#pragma unroll
          for (int g = 0; g < 16; ++g) o += Lop[(t * 16 + g) * 128 + d];
          const float ss = wave_sum(o * o, F.lane);
          Lo[tid] = o; ((LAS float*)(F.lds + GS_G + 2048))[tid >> 6] = ss; }
        __syncthreads();
        { const int t = tid >> 7, d = tid & 127;
          const LAS float* pss = (const LAS float*)(F.lds + GS_G + 2048);
          const float ss = pss[2 * t] + pss[2 * t + 1];
          const float rn = __builtin_amdgcn_rsqf(ss * (1.f / CDV) + EPS);
          const float g = Lg[tid];
          const float val = Lo[tid] * rn * F.in[17][d] * (g * __builtin_amdgcn_rcpf(1.0f + fexp(-g)));
          OUT[(rs_ + t) * D + h * CDV + d] = (bf16)f2bf(val); }
        __syncthreads();
        if (nxt >= NIT) break;
        item = nxt;
#pragma unroll
        for (int i = 0; i < 8; ++i) S[i] = Sn[i];
    }
}

__device__ __forceinline__ void phase_gla(const Ctx& F) {
    const bf16* PROJ = (const bf16*)(F.ws + WS_BR); bf16* OUT = (bf16*)(F.ws + WS_ACT1);
    for (int it = F.vcu; it < NGI; it += F.G) gla_prompt_item(F, PROJ, OUT, it);
}
__device__ __forceinline__ void phase_gla_fix(const Ctx& F) {
    const bf16* PROJ = (const bf16*)(F.ws + WS_BR); bf16* OUT = (bf16*)(F.ws + WS_ACT1);
    for (int it = F.vcu; it < BATCH * CH * (NSEG - 1); it += F.G) gla_fix_item(F, PROJ, OUT, it);
    const Ctx F2 = reopaque(F);
    gla_sample_loop(F2, PROJ, OUT);
}

constexpr int SG_STRIDE = 144, SG_A = 0, SG_B = 128 * SG_STRIDE, SG_STAGE = (128 + 64) * SG_STRIDE;
__device__ __forceinline__ void small_gemm(const Ctx& F, const bf16* A, int lda, const bf16* Bt, int N, int K, bf16* O, int ldc, const float* lb, int lf_c0, int lf_c1, const float* rs, int widx, int wn) {
    if (widx < 0 || widx >= wn) return;
    const int tid = F.tid, lane = F.lane, wave = F.wave, l15 = lane & 15, l4 = lane >> 4;
    const int wm = wave >> 1, wn2 = wave & 1;
    const int nun = (MS / 128) * (N / 64), nk = K / 64;
    LAS unsigned char* L = F.lds;
    const int ar = tid >> 3, akc = tid & 7;
    const unsigned aoffg = (unsigned)((ar * lda + akc * 8) * 2), boffg = (unsigned)((ar * K + akc * 8) * 2);
    const int aoffl = ar * SG_STRIDE + akc * 16;
#pragma unroll 1
    for (int u = widx; u < nun; u += wn) {
        const int rg = u & 3, cg = u >> 2;
        const int row0 = MP + rg * 128, col0 = cg * 64;
        const char* ab = (const char*)A + (long)row0 * lda * 2;
        const char* ab2 = ab + (long)64 * lda * 2;
        const char* bb = (const char*)Bt + (long)col0 * K * 2;
        f32x4 acc[2][2];
#pragma unroll
        for (int i = 0; i < 2; ++i)
#pragma unroll
            for (int j = 0; j < 2; ++j) acc[i][j] = (f32x4){0.f, 0.f, 0.f, 0.f};
        v4u ra0[4], ra1[4], rb[4];
#pragma unroll
        for (int p = 0; p < 4; ++p) { ra0[p] = *(const v4u*)(ab + p * 128 + aoffg); ra1[p] = *(const v4u*)(ab2 + p * 128 + aoffg); rb[p] = *(const v4u*)(bb + p * 128 + boffg); }
        __syncthreads();
#pragma unroll 1
        for (int s4 = 0; s4 < nk; s4 += 4) {
#pragma unroll
            for (int p = 0; p < 4; ++p) {
                const int s = s4 + p;
                LAS unsigned char* cur = L + (p & 1) * SG_STAGE;
                *(LAS v4u*)(cur + SG_A + aoffl) = ra0[p]; *(LAS v4u*)(cur + SG_A + 64 * SG_STRIDE + aoffl) = ra1[p]; *(LAS v4u*)(cur + SG_B + aoffl) = rb[p];
                __syncthreads();
                { const int sn = (s + 4 < nk) ? s + 4 : nk - 1;
                  ra0[p] = *(const v4u*)(ab + sn * 128 + aoffg); ra1[p] = *(const v4u*)(ab2 + sn * 128 + aoffg); rb[p] = *(const v4u*)(bb + sn * 128 + boffg); }
#pragma unroll
                for (int ks = 0; ks < 2; ++ks) {
                    bf16x8 af[2], bfr[2];
#pragma unroll
                    for (int i = 0; i < 2; ++i) af[i] = *(const LAS bf16x8*)(cur + SG_A + (wm * 32 + i * 16 + l15) * SG_STRIDE + (32 * ks + 8 * l4) * 2);
#pragma unroll
                    for (int j = 0; j < 2; ++j) bfr[j] = *(const LAS bf16x8*)(cur + SG_B + (wn2 * 32 + j * 16 + l15) * SG_STRIDE + (32 * ks + 8 * l4) * 2);
#pragma unroll
                    for (int i = 0; i < 2; ++i)
#pragma unroll
                        for (int j = 0; j < 2; ++j) acc[i][j] = __builtin_amdgcn_mfma_f32_16x16x32_bf16(af[i], bfr[j], acc[i][j], 0, 0, 0);
                }
            }
        }
#pragma unroll
        for (int j = 0; j < 2; ++j) {
            const int col = col0 + wn2 * 32 + j * 16 + l15;
            const bool tf = (col >= lf_c0) && (col < lf_c1);
            const float lbv = tf ? lb[col - lf_c0] : 0.f;
#pragma unroll
            for (int i = 0; i < 2; ++i) {
                char* ob = (char*)O + ((long)(row0 + wm * 32 + i * 16) * ldc + col0 + wn2 * 32 + j * 16) * 2;
                const unsigned ooff = (unsigned)((4 * l4 * ldc + l15) * 2);
#pragma unroll
                for (int r = 0; r < 4; ++r) {
                    float v = acc[i][j][r];
                    if (rs) v *= rs[row0 + wm * 32 + i * 16 + 4 * l4 + r];
                    if (tf) v = __builtin_amdgcn_logf(lbv + (1.0f - lbv) * __builtin_amdgcn_rcpf(1.0f + __expf(-v)));
                    *(bf16*)(ob + (long)r * ldc * 2 + ooff) = (bf16)f2bf(v);
                }
            }
        }
    }
}

constexpr int SF_A = 0, SF_BA = 128 * SG_STRIDE, SF_BB = (128 + 64) * SG_STRIDE, SF_STAGE = (128 + 128) * SG_STRIDE;
__device__ __forceinline__ void small_gemm_ffn(const Ctx& F, const bf16* A, int lda, const bf16* Bt, int K, bf16* G, const float* cw, const float* st_in, float* st_out, const float* rs, int widx, int wn) {
    if (widx < 0 || widx >= wn) return;
    const int tid = F.tid, lane = F.lane, wave = F.wave, l15 = lane & 15, l4 = lane >> 4;
    const int wm = wave >> 1, wn2 = wave & 1;
    const int nun = (MS / 128) * (DFF / 64), nk = K / 64;
    LAS unsigned char* L = F.lds;
    const int ar = tid >> 3, akc = tid & 7;
    const unsigned aoffg = (unsigned)((ar * lda + akc * 8) * 2), boffg = (unsigned)((ar * K + akc * 8) * 2);
    const int aoffl = ar * SG_STRIDE + akc * 16;
#pragma unroll 1
    for (int u = widx; u < nun; u += wn) {
        const int rg = u & 3, cg = u >> 2;
        const int row0 = MP + rg * 128, col0 = cg * 64;
        const char* ab = (const char*)A + (long)row0 * lda * 2;
        const char* ab2 = ab + (long)64 * lda * 2;
        const char* bba = (const char*)Bt + (long)(256 * (cg >> 1) + 64 * (cg & 1)) * K * 2;
        const char* bbb = bba + (long)128 * K * 2;
        f32x4 acca[2][2], accb[2][2];
#pragma unroll
        for (int i = 0; i < 2; ++i)
#pragma unroll
            for (int j = 0; j < 2; ++j) { acca[i][j] = (f32x4){0.f, 0.f, 0.f, 0.f}; accb[i][j] = (f32x4){0.f, 0.f, 0.f, 0.f}; }
        v4u ra0[4], ra1[4], rba[4], rbb[4];
#pragma unroll
        for (int p = 0; p < 4; ++p) { ra0[p] = *(const v4u*)(ab + p * 128 + aoffg); ra1[p] = *(const v4u*)(ab2 + p * 128 + aoffg); rba[p] = *(const v4u*)(bba + p * 128 + boffg); rbb[p] = *(const v4u*)(bbb + p * 128 + boffg); }
        __syncthreads();
#pragma unroll 1
        for (int s4 = 0; s4 < nk; s4 += 4) {
#pragma unroll
            for (int p = 0; p < 4; ++p) {
                const int s = s4 + p;
                LAS unsigned char* cur = L + (p & 1) * SF_STAGE;
                *(LAS v4u*)(cur + SF_A + aoffl) = ra0[p]; *(LAS v4u*)(cur + SF_A + 64 * SG_STRIDE + aoffl) = ra1[p]; *(LAS v4u*)(cur + SF_BA + aoffl) = rba[p]; *(LAS v4u*)(cur + SF_BB + aoffl) = rbb[p];
                __syncthreads();
                { const int sn = (s + 4 < nk) ? s + 4 : nk - 1;
                  ra0[p] = *(const v4u*)(ab + sn * 128 + aoffg); ra1[p] = *(const v4u*)(ab2 + sn * 128 + aoffg); rba[p] = *(const v4u*)(bba + sn * 128 + boffg); rbb[p] = *(const v4u*)(bbb + sn * 128 + boffg); }
#pragma unroll
                for (int ks = 0; ks < 2; ++ks) {
                    bf16x8 af[2], bfa[2], bfb[2];
#pragma unroll
                    for (int i = 0; i < 2; ++i) af[i] = *(const LAS bf16x8*)(cur + SF_A + (wm * 32 + i * 16 + l15) * SG_STRIDE + (32 * ks + 8 * l4) * 2);
#pragma unroll
                    for (int j = 0; j < 2; ++j) { bfa[j] = *(const LAS bf16x8*)(cur + SF_BA + (wn2 * 32 + j * 16 + l15) * SG_STRIDE + (32 * ks + 8 * l4) * 2);
                                                  bfb[j] = *(const LAS bf16x8*)(cur + SF_BB + (wn2 * 32 + j * 16 + l15) * SG_STRIDE + (32 * ks + 8 * l4) * 2); }
#pragma unroll
                    for (int i = 0; i < 2; ++i)
#pragma unroll
                        for (int j = 0; j < 2; ++j) { acca[i][j] = __builtin_amdgcn_mfma_f32_16x16x32_bf16(af[i], bfa[j], acca[i][j], 0, 0, 0); accb[i][j] = __builtin_amdgcn_mfma_f32_16x16x32_bf16(af[i], bfb[j], accb[i][j], 0, 0, 0); }
                }
            }
        }
#pragma unroll
        for (int j = 0; j < 2; ++j) {
            const int c = col0 + wn2 * 32 + j * 16 + l15;
            const float w0 = cw[c], w1 = cw[DFF + c], w2 = cw[2 * DFF + c];
#pragma unroll
            for (int i = 0; i < 2; ++i) {
                const int sq = (rg * 128 + wm * 32 + i * 16 + 4 * l4) >> 2;
                float am2 = st_in[(size_t)sq * 2 * DFF + c], am1 = st_in[(size_t)sq * 2 * DFF + DFF + c];
#pragma unroll
                for (int r = 0; r < 4; ++r) {
                    const float rsc = rs[MP + sq * 4 + r];
                    const float a = acca[i][j][r] * rsc;
                    const float y = w0 * am2 + w1 * am1 + w2 * a;
                    G[(size_t)(MP + sq * 4 + r) * DFF + c] = (bf16)f2bf(gelu_tanh(y) * (accb[i][j][r] * rsc));
                    am2 = am1; am1 = a;
                }
                st_out[(size_t)sq * 2 * DFF + c] = am2; st_out[(size_t)sq * 2 * DFF + DFF + c] = am1;
            }
        }
    }
}

struct Args { const float* in[22]; float* out; unsigned char* ws; int ph_lo, ph_hi; };
__global__ void __launch_bounds__(NWAVES * 64, 2) trunk_fwd(Args args) {
    extern __shared__ __attribute__((aligned(16))) unsigned char lds_raw[];
    LAS unsigned char* const lds0 = (LAS unsigned char*)lds_raw;
    volatile LAS unsigned* MISC = (volatile LAS unsigned*)(lds0 + MISC_OFF);
    for (int u = threadIdx.x; u < (LDS_BYTES - LDSCTL_OFF) / 4; u += NWAVES * 64) ((LAS unsigned*)(lds0 + LDSCTL_OFF))[u] = 0u;
    __syncthreads();
    gu32* ctl = (gu32*)(args.ws + WS_CTL);
    XcdBarrier bar; bar.bar = (unsigned*)(ctl + CW_BAR); bar.x = 0; bar.st = nullptr;
    const int lo = args.ph_lo, hi = args.ph_hi;
    if (hi - lo > 1) bar = xcd_barrier_post((unsigned*)(ctl + CW_BAR), MISC + 8);

#ifdef REPMASK
    bool rep_done = false;
#endif
    const int wave0 = __builtin_amdgcn_readfirstlane((int)threadIdx.x >> 6);
    for (int ph = lo; ph < hi; ++ph) {
        int bx_ = blockIdx.x; asm volatile("" : "+s"(bx_));
#define MKCTX() Ctx F; { int lane_; asm volatile("v_mbcnt_lo_u32_b32 %0, -1, 0\n\tv_mbcnt_hi_u32_b32 %0, -1, %0" : "=v"(lane_)); \
        F.lds = lds0; F.tid = wave0 * 64 + lane_; F.lane = lane_; F.wave = wave0; F.G = gridDim.x; F.vcu = (F.G % 8 == 0) ? (bx_ % 8) * (F.G / 8) + bx_ / 8 : bx_; \
        _Pragma("unroll") for (int i = 0; i < 22; ++i) F.in[i] = args.in[i]; \
        size_t z_ = 0; asm volatile("" : "+s"(z_)); F.out = args.out + z_; F.ws = args.ws + z_; }   \
        bf16* ACT1 = (bf16*)(F.ws + WS_ACT1); bf16* BR = (bf16*)(F.ws + WS_BR); bf16* MIX = (bf16*)(F.ws + WS_MIX); const float* LB = (const float*)(F.ws + WS_LB); \
        (void)ACT1; (void)BR; (void)MIX; (void)LB;
        switch (ph) {
        case 0: { MKCTX(); phase_prologue(F); } break;
        case 1: case 3: case 5: case 7: case 9: case 12: case 14: case 16: {
            MKCTX();
            const bf16* XBp = (const bf16*)(F.ws + WS_XB); const float* RS = (const float*)(F.ws + WS_RS);
            pg8::Gemm g; pg8::EpiGen E; E.lb = LB; E.lf_lo = 0; E.lf_hi = 0; E.mode = 0; E.cw = nullptr; E.halo = nullptr; E.a01 = nullptr; E.b01 = nullptr; E.stout = nullptr; E.xb = F.lds + XB_OFF; E.rs = nullptr;
            const int ffl = (ph == 5) ? 0 : 1;
            if (ph == 1)       { g = pg8::Gemm{XBp, (const bf16*)(F.ws + W_INAB), MP, DINAB, D, D};   E.O = BR;  E.ldc = DINAB; E.rs = RS; }
            else if (ph == 3)  { g = pg8::Gemm{ACT1, (const bf16*)(F.ws + W_OUTAB), MP, D, D, D};     E.O = MIX; E.ldc = D; }
            else if (ph == 5 || ph == 14) { g = pg8::Gemm{XBp, (const bf16*)(F.ws + (ph == 5 ? W_UP0 : W_UP1)), MP, DUP, D, D}; E.O = BR; E.ldc = DFF; E.mode = 1; E.rs = RS;
                                 E.cw = F.in[20] + (size_t)ffl * 3 * DFF; E.halo = (float*)(F.ws + WS_HALO); E.a01 = (float*)(F.ws + WS_A01); E.b01 = (float*)(F.ws + WS_B01); E.stout = F.out + O_FP + (size_t)ffl * BATCH * 2 * DFF; }
            else if (ph == 7)  { g = pg8::Gemm{BR, (const bf16*)(F.ws + W_DN0), MP, D, DFF, DFF};     E.O = ACT1; E.ldc = D; }
            else if (ph == 9)  { g = pg8::Gemm{XBp, (const bf16*)(F.ws + W_INC), MP, DINC, D, D};     E.O = BR;  E.ldc = DINC; E.rs = RS; }
            else if (ph == 12) { g = pg8::Gemm{ACT1, (const bf16*)(F.ws + W_OUTC), MP, D, D, D};      E.O = MIX; E.ldc = D; }
            else               { g = pg8::Gemm{BR, (const bf16*)(F.ws + W_DN1), MP, D, DFF, DFF};     E.O = ACT1; E.ldc = D; }
            pg8::StaticOrder S; S.init(g.M, g.N, F.G, bx_);
            pg8::gemm_phase<pg8::EpiGen, pg8::StaticOrder, true, true>(F.lds, g, S, E, F.tid);
            const Ctx F2 = reopaque(F);
            if (ph == 1) small_gemm(F2, g.A, g.lda, g.Bt, g.N, g.K, E.O, E.ldc, LB, 0, 0, E.rs, bx_ - 128, 128);
            else if (ph == 5 || ph == 14) small_gemm_ffn(F2, g.A, g.lda, g.Bt, g.K, BR, F.in[20] + (size_t)ffl * 3 * DFF, F.in[6] + (size_t)ffl * NB * 2 * DFF, F.out + O_FS + (size_t)ffl * NB * 2 * DFF, RS, F.vcu, F.G);
            else small_gemm(F2, g.A, g.lda, g.Bt, g.N, g.K, E.O, E.ldc, LB, E.lf_lo * 256, E.lf_hi * 256, E.rs, F.vcu, F.G);
        } break;
        case 2: { MKCTX(); phase_mixer_ab(F); } break;
        case 4:  { MKCTX(); phase_rowwise<0>(F, MIX, F.in[8]); } break;
        case 6:  { MKCTX(); phase_ffnfix(F, 0); } break;
        case 8:  { MKCTX(); phase_rowwise<1>(F, ACT1, F.in[10]); } break;
        case 10: { MKCTX(); phase_gla(F); } break;
        case 11: { MKCTX(); phase_gla_fix(F); } break;
        case 13: { MKCTX(); phase_rowwise<1>(F, MIX, F.in[8] + D); } break;
        case 15: { MKCTX(); phase_ffnfix(F, 1); } break;
        case 17: { MKCTX(); phase_rowwise<2>(F, ACT1, F.in[10] + D); } break;
        default: break;
        }
#ifdef REPMASK
        if (((REPMASK >> ph) & 1) && !rep_done) { rep_done = true; xcd_barrier(bar); --ph; continue; }
        rep_done = false;
#endif
        if (ph + 1 < hi) xcd_barrier(bar);
    }
}

extern "C" void kernel_launch(void* const* d_in, const int* in_sizes, int n_in, void* d_out, int out_size, void* d_ws, size_t ws_size, hipStream_t stream) {
    static int grid = 0;
    if (grid == 0) {
        if (n_in != 22 || (size_t)out_size != O_END || ws_size < 512 * MiB) { fprintf(stderr, "kernel_launch: unexpected shapes (n_in %d, out %d, ws %zu); nothing launched\n", n_in, out_size, ws_size); grid = -1; return; }
        int dev = 0, cus = 0, per_cu = 0;
        if (hipGetDevice(&dev) != hipSuccess || hipDeviceGetAttribute(&cus, hipDeviceAttributeMultiprocessorCount, dev) != hipSuccess) { grid = -1; return; }
        if (hipFuncSetAttribute((const void*)trunk_fwd, hipFuncAttributeMaxDynamicSharedMemorySize, LDS_BYTES) != hipSuccess) { fprintf(stderr, "kernel_launch: hipFuncSetAttribute failed\n"); grid = -1; return; }
        if (hipOccupancyMaxActiveBlocksPerMultiprocessor(&per_cu, (const void*)trunk_fwd, NWAVES * 64, LDS_BYTES) != hipSuccess || per_cu < 1)
            fprintf(stderr, "kernel_launch: occupancy query reports %d workgroups per CU\n", per_cu);
        (void)hipGetLastError();
        grid = cus;
    }
    if (grid < 0) return;
    if (hipMemsetAsync((char*)d_ws + WS_CTL, 0, CTL_ZERO_BYTES, stream) != hipSuccess) { fprintf(stderr, "kernel_launch: memset failed\n"); return; }
    Args a{};
    for (int i = 0; i < 22; ++i) a.in[i] = (const float*)d_in[i];
    a.out = (float*)d_out; a.ws = (unsigned char*)d_ws;
    const int per = (N_PHASES + N_LAUNCHES - 1) / N_LAUNCHES;
    for (int li = 0; li < N_LAUNCHES; ++li) {
        a.ph_lo = li * per; a.ph_hi = (li + 1) * per < N_PHASES ? (li + 1) * per : N_PHASES;
        if (a.ph_lo >= a.ph_hi) break;
        hipLaunchKernelGGL(trunk_fwd, dim3(grid), dim3(NWAVES * 64), LDS_BYTES, stream, a);
        const hipError_t le = hipPeekAtLastError();
        if (le != hipSuccess) { fprintf(stderr, "kernel_launch: launch %d failed: %s\n", li, hipGetErrorName(le)); break; }
    }
}
```
